# Optimizing an MI355X kernel written in HIP

```python
import math
import jax, jax.numpy as jnp
from jax import lax
import numpy as np

D_MODEL = 4096
BATCH = 2
SEQ = 8192
DEPTH = 2
DEC_BATCH = 4
DEC_SEQ = 4096
PAST_LEN = 128

PLE_DIM = 256
GRID_W = 64
MIX_WIDTH = D_MODEL
POOL_WIDTH = MIX_WIDTH // 4
POOL_WINDOWS = (2, 4, 8, 16)
POOL_GROUP = POOL_WIDTH // len(POOL_WINDOWS)
MLSTM_WIDTH = MIX_WIDTH // 4
MLSTM_HEADS = 4
MLSTM_HEAD_DIM = MLSTM_WIDTH // MLSTM_HEADS
MLSTM_CHUNK = 64
ATTN_WIDTH = MIX_WIDTH - POOL_WIDTH - MLSTM_WIDTH
ATTN_HEAD_DIM = 128
ATTN_HEADS = ATTN_WIDTH // ATTN_HEAD_DIM
ATTN_KV_HEADS = 4
ATTN_GROUP = ATTN_HEADS // ATTN_KV_HEADS
KV_WIDTH = ATTN_KV_HEADS * ATTN_HEAD_DIM
ROPE_AXIS_DIM = ATTN_HEAD_DIM // 2
ROPE_THETA = 10000.0
Q_BLOCK = 128
N_GATES = 4 * MLSTM_HEADS
EPS = 1e-6
IN_SPLITS = (POOL_WIDTH, POOL_WIDTH,
             MLSTM_WIDTH, MLSTM_WIDTH, MLSTM_WIDTH, MLSTM_WIDTH, MLSTM_WIDTH, N_GATES,
             ATTN_WIDTH, KV_WIDTH, KV_WIDTH, ATTN_WIDTH)
IN_WIDTH = sum(IN_SPLITS)

kernel_name = 'hybrid_pool_mlstm_gqa_encoder'


def rmsnorm(x, g):
    xf = x.astype(jnp.float32)
    r = lax.rsqrt(jnp.mean(xf * xf, axis=-1, keepdims=True) + EPS)
    return (xf * r * g.astype(jnp.float32)).astype(x.dtype)


def pool_mixer(u, z, w_pool, scale):
    S = u.shape[1]
    uf = u.astype(jnp.float32)
    cs = jnp.concatenate([jnp.zeros_like(uf[:, :1]), jnp.cumsum(uf, axis=1)], axis=1)
    t = jnp.arange(S)
    outs = []
    for g, w in enumerate(POOL_WINDOWS):
        sl = slice(g * POOL_GROUP, (g + 1) * POOL_GROUP)
        lo = jnp.clip(t - w // 2, 0, S - 1)
        hi = jnp.clip(t + w // 2 - 1, 0, S - 1)
        cnt = (hi - lo + 1).astype(jnp.float32)
        csg = cs[..., sl]
        mean = (jnp.take(csg, hi + 1, axis=1) - jnp.take(csg, lo, axis=1)) / cnt[None, :, None]
        d = (mean - uf[..., sl]).astype(u.dtype)
        outs.append(jnp.einsum('bsc,cd->bsd', d, w_pool[g]))
    y = jnp.concatenate(outs, axis=-1) * scale
    return y * jax.nn.silu(z)


def mlstm_scan(q, k, v, logi, logf):
    B, H, S, dk = q.shape
    dv = v.shape[-1]
    L = MLSTM_CHUNK
    NC = S // L

    def chunks(a):
        return jnp.moveaxis(a.reshape(B, H, NC, L, *a.shape[3:]), 2, 0)

    mask = jnp.tril(jnp.ones((L, L), dtype=bool))

    def body(carry, inp):
        C, n, m = carry
        qc, kc, vc, li, lf = inp
        b = jnp.cumsum(lf, axis=-1)
        D = b[..., :, None] - b[..., None, :] + li[..., None, :]
        D = jnp.where(mask, D, -jnp.inf)
        m_inter = b + m[..., None]
        m_row = jnp.maximum(m_inter, jnp.max(D, axis=-1))
        w_intra = jnp.exp(D - m_row[..., None])
        w_inter = jnp.exp(m_inter - m_row)
        s = jnp.einsum('bhid,bhjd->bhij', qc, kc) * w_intra
        num = (jnp.einsum('bhij,bhje->bhie', s, vc)
               + w_inter[..., None] * jnp.einsum('bhid,bhde->bhie', qc, C))
        den = jnp.sum(s, axis=-1) + w_inter * jnp.einsum('bhid,bhd->bhi', qc, n)
        h = num / jnp.maximum(jnp.abs(den), jnp.exp(-m_row))[..., None]
        bL = b[..., -1]
        w_r = bL[..., None] - b + li
        m_new = jnp.maximum(bL + m, jnp.max(w_r, axis=-1))
        decay = jnp.exp(bL + m - m_new)
        wk = jnp.exp(w_r - m_new[..., None])
        C_new = decay[..., None, None] * C + jnp.einsum('bhj,bhjd,bhje->bhde', wk, kc, vc)
        n_new = decay[..., None] * n + jnp.einsum('bhj,bhjd->bhd', wk, kc)
        return (C_new, n_new, m_new), h

    init = (jnp.zeros((B, H, dk, dv), jnp.float32),
            jnp.zeros((B, H, dk), jnp.float32),
            jnp.zeros((B, H), jnp.float32))
    _, hs = lax.scan(body, init, (chunks(q), chunks(k), chunks(v), chunks(logi), chunks(logf)))
    return jnp.moveaxis(hs, 0, 2).reshape(B, H, S, dv)


def mlstm_mixer(q, k, v, o, z, gates, b_gate, norm_g):
    B, S, _ = q.shape

    def heads(a):
        return a.astype(jnp.float32).reshape(B, S, MLSTM_HEADS, MLSTM_HEAD_DIM).transpose(0, 2, 1, 3)

    qh = heads(q) * (MLSTM_HEAD_DIM ** -0.5)
    kh = heads(k)
    vh = heads(v)
    gt = (gates.astype(jnp.float32) + b_gate.astype(jnp.float32)).transpose(0, 2, 1)
    i_f, f_f, i_b, f_b = jnp.split(gt, 4, axis=1)
    h_fwd = mlstm_scan(qh, kh, vh, i_f, jax.nn.log_sigmoid(f_f))
    flip = lambda a: jnp.flip(a, axis=2)
    h_bwd = flip(mlstm_scan(flip(qh), flip(kh), flip(vh), flip(i_b), flip(jax.nn.log_sigmoid(f_b))))
    h = (h_fwd + h_bwd).transpose(0, 2, 1, 3)
    h = h * lax.rsqrt(jnp.mean(h * h, axis=-1, keepdims=True) + EPS)
    h = h.reshape(B, S, MLSTM_WIDTH) * norm_g.astype(jnp.float32)
    h = h * jax.nn.sigmoid(o.astype(jnp.float32))
    return h.astype(q.dtype) * jax.nn.silu(z)


def rope_half(x, ang):
    c = jnp.cos(ang)[None, :, None, :]
    s = jnp.sin(ang)[None, :, None, :]
    xa, xb = jnp.split(x, 2, axis=-1)
    return jnp.concatenate([xa * c - xb * s, xb * c + xa * s], axis=-1)


def rope_2d(x, ang_r, ang_c):
    xr, xc = jnp.split(x, 2, axis=-1)
    return jnp.concatenate([rope_half(xr, ang_r), rope_half(xc, ang_c)], axis=-1)


def attn_mixer(q, k, v, z, q_norm, k_norm, rows):
    B, S, _ = q.shape
    qh = rmsnorm(q.reshape(B, S, ATTN_HEADS, ATTN_HEAD_DIM), q_norm).astype(jnp.float32)
    kh = rmsnorm(k.reshape(B, S, ATTN_KV_HEADS, ATTN_HEAD_DIM), k_norm).astype(jnp.float32)
    vh = v.reshape(B, S, ATTN_KV_HEADS, ATTN_HEAD_DIM).astype(jnp.float32)
    row_ids = jnp.repeat(jnp.arange(rows), GRID_W).astype(jnp.float32)
    col_ids = jnp.tile(jnp.arange(GRID_W), rows).astype(jnp.float32)
    nf = ROPE_AXIS_DIM // 2
    inv = ROPE_THETA ** (-jnp.arange(nf, dtype=jnp.float32) / nf)
    ang_r = row_ids[:, None] * inv
    ang_c = col_ids[:, None] * inv
    qh = rope_2d(qh, ang_r, ang_c)
    kh = rope_2d(kh, ang_r, ang_c)
    NB = S // Q_BLOCK
    qb = qh.reshape(B, NB, Q_BLOCK, ATTN_KV_HEADS, ATTN_GROUP, ATTN_HEAD_DIM).transpose(1, 0, 3, 4, 2, 5)
    kt = kh.transpose(0, 2, 1, 3)
    vt = vh.transpose(0, 2, 1, 3)
    scale = ATTN_HEAD_DIM ** -0.5

    def block(qblk):
        s = jnp.einsum('bkgqd,bksd->bkgqs', qblk, kt) * scale
        p = jax.nn.softmax(s, axis=-1)
        return jnp.einsum('bkgqs,bksd->bkgqd', p, vt)

    ob = lax.map(block, qb)
    o = ob.transpose(1, 0, 4, 2, 3, 5).reshape(B, S, ATTN_WIDTH)
    return o.astype(q.dtype) * jax.nn.silu(z)


def layer(x, p, rows, norm_pre, w_in, b_gate, w_pool, pool_scale, mlstm_norm,
          q_norm, k_norm, w_out, norm_post, w_ple_proj, w_ple_gate, ple_norm):
    h = rmsnorm(x, norm_pre)
    zin = jnp.einsum('bsd,de->bse', h, w_in)
    offs = np.cumsum(IN_SPLITS)[:-1].tolist()
    (pu, pz, mq, mk, mv, mo, mz, mg, aq, ak, av, az) = jnp.split(zin, offs, axis=-1)
    y_pool = pool_mixer(pu, pz, w_pool, pool_scale)
    y_ml = mlstm_mixer(mq, mk, mv, mo, mz, mg, b_gate, mlstm_norm)
    y_att = attn_mixer(aq, ak, av, az, q_norm, k_norm, rows)
    y = jnp.concatenate([y_pool, y_ml, y_att], axis=-1)
    y = jnp.einsum('bsc,cd->bsd', y, w_out)
    x = x + rmsnorm(y, norm_post)
    ple = jnp.einsum('bsr,rd->bsd', p, w_ple_proj) * jax.nn.sigmoid(jnp.einsum('bsd,de->bse', x, w_ple_gate))
    return x + rmsnorm(ple, ple_norm)


def trunk(x, p, norm_pre, w_in, b_gate, w_pool, pool_scale, mlstm_norm,
          q_norm, k_norm, w_out, norm_post, w_ple_proj, w_ple_gate, ple_norm):
    rows = x.shape[1] // GRID_W
    for i in range(DEPTH):
        x = layer(x, p[i], rows, norm_pre[i], w_in[i], b_gate[i], w_pool[i], pool_scale[i],
                  mlstm_norm[i], q_norm[i], k_norm[i], w_out[i], norm_post[i],
                  w_ple_proj[i], w_ple_gate[i], ple_norm[i])
    return x


def setup_inputs(seed: int = 0) -> dict:
    key = jax.random.key(seed)
    ks = jax.random.split(key, 20)
    f32 = jnp.float32
    nrm = lambda k, shape: jax.random.normal(k, shape, f32)
    x_prompt = nrm(ks[0], (BATCH, SEQ, D_MODEL))
    x_sample = nrm(ks[1], (DEC_BATCH, DEC_SEQ, D_MODEL))
    p_prompt = nrm(ks[2], (DEPTH, BATCH, SEQ, PLE_DIM))
    p_sample = nrm(ks[3], (DEPTH, DEC_BATCH, DEC_SEQ, PLE_DIM))
    norm_pre = 1.0 + 0.1 * nrm(ks[4], (DEPTH, D_MODEL))
    w_in = nrm(ks[5], (DEPTH, D_MODEL, IN_WIDTH)) * (D_MODEL ** -0.5)
    i_base = jnp.full((MLSTM_HEADS,), -1.0, f32)
    f_base = jnp.linspace(3.0, 6.0, MLSTM_HEADS, dtype=f32)
    gate_base = jnp.concatenate([i_base, f_base, i_base, f_base])
    b_gate = gate_base[None, :] + 0.1 * nrm(ks[6], (DEPTH, N_GATES))
    w_pool = nrm(ks[7], (DEPTH, len(POOL_WINDOWS), POOL_GROUP, POOL_GROUP)) * (POOL_GROUP ** -0.5)
    pool_scale = 1.0 + 0.1 * nrm(ks[8], (DEPTH, POOL_WIDTH))
    mlstm_norm = 1.0 + 0.1 * nrm(ks[9], (DEPTH, MLSTM_WIDTH))
    q_norm = 1.0 + 0.1 * nrm(ks[10], (DEPTH, ATTN_HEAD_DIM))
    k_norm = 1.0 + 0.1 * nrm(ks[11], (DEPTH, ATTN_HEAD_DIM))
    w_out = nrm(ks[12], (DEPTH, MIX_WIDTH, D_MODEL)) * (MIX_WIDTH ** -0.5)
    norm_post = 1.0 + 0.1 * nrm(ks[13], (DEPTH, D_MODEL))
    w_ple_proj = nrm(ks[14], (DEPTH, PLE_DIM, D_MODEL)) * (PLE_DIM ** -0.5)
    w_ple_gate = nrm(ks[15], (DEPTH, D_MODEL, D_MODEL)) * (D_MODEL ** -0.5)
    ple_norm = 1.0 + 0.1 * nrm(ks[16], (DEPTH, D_MODEL))
    return {'x_prompt': x_prompt, 'x_sample': x_sample, 'p_prompt': p_prompt, 'p_sample': p_sample,
            'norm_pre': norm_pre, 'w_in': w_in, 'b_gate': b_gate, 'w_pool': w_pool,
            'pool_scale': pool_scale, 'mlstm_norm': mlstm_norm, 'q_norm': q_norm, 'k_norm': k_norm,
            'w_out': w_out, 'norm_post': norm_post, 'w_ple_proj': w_ple_proj,
            'w_ple_gate': w_ple_gate, 'ple_norm': ple_norm}


def reference(x_prompt, x_sample, p_prompt, p_sample, norm_pre, w_in, b_gate, w_pool,
              pool_scale, mlstm_norm, q_norm, k_norm, w_out, norm_post, w_ple_proj,
              w_ple_gate, ple_norm):
    y_prompt = trunk(x_prompt, p_prompt, norm_pre, w_in, b_gate, w_pool, pool_scale, mlstm_norm,
                     q_norm, k_norm, w_out, norm_post, w_ple_proj, w_ple_gate, ple_norm)
    y_sample = trunk(x_sample, p_sample, norm_pre, w_in, b_gate, w_pool, pool_scale, mlstm_norm,
                     q_norm, k_norm, w_out, norm_post, w_ple_proj, w_ple_gate, ple_norm)
    return (y_prompt, y_sample)
```

```cpp
#include <hip/hip_runtime.h>
#include <cstdio>
#include <cstdint>

#ifndef PROBE_INPROJ
#define PROBE_INPROJ 1
#endif
#ifndef PROBE_ATTN
#define PROBE_ATTN 1
#endif
#ifndef PROBE_MLSTM
#define PROBE_MLSTM 1
#endif
#ifndef PROBE_OUTPROJ
#define PROBE_OUTPROJ 1
#endif
#ifndef PROBE_GATE
#define PROBE_GATE 1
#endif
#ifndef PROBE_SMALLGEMM
#define PROBE_SMALLGEMM 1
#endif
#ifndef PROBE_PRO
#define PROBE_PRO 1
#endif
#ifndef PROBE_X1
#define PROBE_X1 1
#endif
#ifndef PROBE_BAR
#define PROBE_BAR 0
#endif
#ifndef PROBE_MIX
#define PROBE_MIX 1
#endif
#ifndef MK_ONE_LAUNCH
#define MK_ONE_LAUNCH 1
#endif

constexpr int DM = 4096, NTOK = 32768, NPROMPT = 16384, NIN = 12288, NINSRC = 12304, DEPTH = 2, PLE = 256;
constexpr int C_PU = 0, C_PZ = 1024, C_MQ = 2048, C_MK = 3072, C_MV = 4096, C_MO = 5120, C_MZ = 6144, C_AQ = 7168, C_AK = 9216, C_AV = 9728, C_AZ = 10240;
constexpr float EPS = 1e-6f;
constexpr int NWAVES = 8;

constexpr size_t MiB = 1u << 20;
constexpr size_t WS_CTL = 0, CTL_ZERO_BYTES = 1 * MiB;
constexpr size_t WS_ROPE = 1 * MiB;
constexpr size_t WS_ABOUND = 1 * MiB + 768 * 1024;
constexpr size_t WS_WG = 2 * MiB;
constexpr size_t WS_GATES = 3 * MiB;
constexpr size_t WS_WPOOL = 5 * MiB;
constexpr size_t WS_WPROJ = 6 * MiB;
constexpr size_t WS_STATS = 8 * MiB;
constexpr size_t WS_PB = 16 * MiB;
constexpr size_t WS_WOUT = 48 * MiB;
constexpr size_t WS_WGATE = 80 * MiB;
constexpr size_t WS_WIN = 112 * MiB;
constexpr size_t WS_H = 208 * MiB;
constexpr size_t WS_DPOOL = WS_H;
constexpr size_t WS_HF = WS_H + 64 * MiB;
constexpr size_t WS_HB = WS_H + 128 * MiB;
constexpr size_t WS_KC = WS_H + 192 * MiB;
constexpr size_t WS_VC = WS_H + 224 * MiB;
constexpr size_t WS_Y = 464 * MiB;
constexpr size_t WS_ZIN = 720 * MiB;
constexpr size_t WS_YO = WS_ZIN;
constexpr size_t WS_PP = WS_ZIN + 256 * MiB;
constexpr size_t WS_GSC = 1488 * MiB;
constexpr size_t WS_CHS = 1492 * MiB;
constexpr size_t WS_END = 1493 * MiB;

constexpr int RING_BYTES = 131072;
constexpr int LDS_BYTES = 147456;
constexpr int MISC_OFF = LDS_BYTES - 256;

#define LAS __attribute__((address_space(3)))
typedef unsigned short bf16_t;
typedef short bf16x8 __attribute__((ext_vector_type(8)));
typedef short s16x4 __attribute__((ext_vector_type(4)));
typedef float f32x4 __attribute__((ext_vector_type(4)));
typedef float f32x2 __attribute__((ext_vector_type(2)));
typedef float f32x8 __attribute__((ext_vector_type(8)));
typedef float f32x16 __attribute__((ext_vector_type(16)));
typedef unsigned u32x4 __attribute__((ext_vector_type(4)));
typedef unsigned u32x2 __attribute__((ext_vector_type(2)));

__device__ __forceinline__ unsigned cvt_pk_bf16(float lo, float hi) { unsigned r; asm volatile("v_cvt_pk_bf16_f32 %0, %1, %2" : "=v"(r) : "v"(lo), "v"(hi)); return r; }
__device__ __forceinline__ bf16_t f2bf(float f) { return (bf16_t)(cvt_pk_bf16(f, 0.f) & 0xffffu); }
__device__ __forceinline__ float bf2f(bf16_t b) { return __uint_as_float(((unsigned)b) << 16); }
__device__ __forceinline__ float bflo(unsigned w) { return __uint_as_float(w << 16); }
__device__ __forceinline__ float bfhi(unsigned w) { return __uint_as_float(w & 0xffff0000u); }
template <int K> __device__ __forceinline__ float swz_xor(float v) { static_assert(K >= 1 && K <= 16, "ds_swizzle reaches 32 lanes"); return __int_as_float(__builtin_amdgcn_ds_swizzle(__float_as_int(v), 0x1F | (K << 10))); }
template <int K> __device__ __forceinline__ float addx(float v) {
    if constexpr (K == 32) { auto rr = __builtin_amdgcn_permlane32_swap(__float_as_uint(v), __float_as_uint(v), false, false); return __uint_as_float(rr[0]) + __uint_as_float(rr[1]); }
    else return v + swz_xor<K>(v);
}
__device__ __forceinline__ float wave_sum(float v) { v = addx<1>(v); v = addx<2>(v); v = addx<4>(v); v = addx<8>(v); v = addx<16>(v); return addx<32>(v); }
__device__ __forceinline__ float shfl_from(float v, int srclane) { return __int_as_float(__builtin_amdgcn_ds_bpermute(srclane << 2, __float_as_int(v))); }
__device__ __forceinline__ int opaque_tid() { int t = threadIdx.x; asm volatile("" : "+v"(t)); return t; }
__device__ __forceinline__ float fast_exp(float x) { return __builtin_amdgcn_exp2f(x * 1.4426950408889634f); }
__device__ __forceinline__ float sigmoidf_(float x) { return __builtin_amdgcn_rcpf(1.f + fast_exp(-x)); }
__device__ __forceinline__ float siluf_(float x) { return x * sigmoidf_(x); }
#define LDS_WAIT() asm volatile("s_waitcnt lgkmcnt(0)" ::: "memory")
#define VM_WAIT() asm volatile("s_waitcnt vmcnt(0)" ::: "memory")
#define SBAR() __builtin_amdgcn_sched_barrier(0)

#define XB_TMO      128
#define XB_XCNT(j)  (256  + 64 * (j))
#define XB_XSUB(j)  (1280 + 64 * (j))
#define XB_XGEN(j)  (2304 + 64 * (j))
#define XB_TOP      3328
#define XB_TOPGEN   3392
#define XCD_BAR_WORDS 3456
#define XB_SPIN_CAP (1u << 22)
__device__ __forceinline__ unsigned xb_ld(unsigned* p)              { return __hip_atomic_load(p, __ATOMIC_RELAXED, __HIP_MEMORY_SCOPE_AGENT); }
__device__ __forceinline__ unsigned xb_add(unsigned* p, unsigned v) { return __hip_atomic_fetch_add(p, v, __ATOMIC_RELAXED, __HIP_MEMORY_SCOPE_AGENT); }
__device__ __forceinline__ unsigned xb_xcc_id() { return (unsigned)__builtin_amdgcn_s_getreg((3 << 11) | 20) & 0xFu; }
#define XB_SPIN(cond, bar) do { unsigned _sp = 0; while (cond) { __builtin_amdgcn_s_sleep(1); \
    if ((++_sp & 255u) == 0u) { if (xb_ld(&(bar)[XB_TMO])) break; if (_sp > XB_SPIN_CAP) { atomicAdd(&(bar)[XB_TMO], 1u); break; } } } } while (0)
struct XcdBarrier { unsigned* bar; unsigned x; volatile LAS unsigned* st; };
__device__ __forceinline__ XcdBarrier xcd_barrier_post(unsigned* bar, volatile LAS unsigned* st) {
    XcdBarrier b; b.bar = bar; b.x = xb_xcc_id(); b.st = st;
    if (threadIdx.x == 0) (void)xb_add(&bar[XB_XCNT(b.x)], 1u);
    return b;
}
__device__ __forceinline__ void xcd_barrier_complete(unsigned* bar, unsigned x, unsigned& nloc, unsigned& nx) {
    const unsigned G = gridDim.x * gridDim.y * gridDim.z;
    unsigned sum, cnt, mine, sp = 0u;
    for (;;) {
        sum = 0u; cnt = 0u; mine = 0u;
#pragma unroll
        for (unsigned j = 0; j < 16; ++j) { const unsigned c = xb_ld(&bar[XB_XCNT(j)]); sum += c; cnt += (c > 0u) ? 1u : 0u; mine = (j == x) ? c : mine; }
        if (sum == G) break;
        __builtin_amdgcn_s_sleep(1);
        if ((++sp & 255u) == 0u) { if (xb_ld(&bar[XB_TMO])) break; if (sp > XB_SPIN_CAP) { atomicAdd(&bar[XB_TMO], 1u); break; } }
    }
    nloc = mine > 0u ? mine : 1u; nx = cnt > 0u ? cnt : 1u;
}
__device__ __forceinline__ void xcd_barrier(const XcdBarrier& b) {
    asm volatile("s_waitcnt vmcnt(0)" ::: "memory");
    __syncthreads();
    if (threadIdx.x == 0) {
        unsigned* bar = b.bar;
        __builtin_amdgcn_s_waitcnt(0);
        unsigned nloc = b.st[0], nx = b.st[1];
        if (nloc == 0u) { xcd_barrier_complete(bar, b.x, nloc, nx); b.st[0] = nloc; b.st[1] = nx; }
        const unsigned old = xb_add(&bar[XB_XSUB(b.x)], 1u);
        const unsigned gen = old / nloc;
        if (old + 1u == (gen + 1u) * nloc) {
            __builtin_amdgcn_fence(__ATOMIC_RELEASE, "agent");
            asm volatile("s_waitcnt vmcnt(0)" ::: "memory");
            const unsigned og = xb_add(&bar[XB_TOP], 1u);
            const unsigned tg = og / nx;
            if (og + 1u == (tg + 1u) * nx) xb_add(&bar[XB_TOPGEN], 1u);
            else XB_SPIN(xb_ld(&bar[XB_TOPGEN]) == tg, bar);
            __builtin_amdgcn_fence(__ATOMIC_ACQUIRE, "agent");
            xb_add(&bar[XB_XGEN(b.x)], 1u);
            asm volatile("s_waitcnt vmcnt(0)" ::: "memory");
        } else {
            XB_SPIN(xb_ld(&bar[XB_XGEN(b.x)]) == gen, bar);
            __builtin_amdgcn_fence(__ATOMIC_ACQUIRE, "agent");
            asm volatile("s_waitcnt vmcnt(0)" ::: "memory");
        }
    }
    __syncthreads();
}

#ifndef PG8_SP2
#define PG8_SP2 true
#endif
namespace pg8 {
constexpr int BM = 256, BK = 64, HALF = 128, HTB = HALF * BK * 2, STAGE_BYTES = 8 * HTB, NXCD = 8, WGM = 8;
__host__ __device__ __forceinline__ int lds_byte(int r, int c) { const int st = (r >> 4) * 2 + (c >> 5), rr = r & 15, cc = c & 31, ob = rr * 64 + cc * 2; return st * 1024 + (ob ^ (((ob >> 9) & 1) << 5)); }
__host__ __device__ __forceinline__ void stage_rc(int b, int& R, int& C) { const int st = b / 1024, sb = b % 1024, swz = sb ^ (((sb >> 9) & 1) << 5); R = (st >> 1) * 16 + swz / 64; C = (st & 1) * 32 + (swz % 64) / 2; }
__host__ __device__ __forceinline__ int perm32(int rho) { const int n = rho >> 4, i = rho & 15; return 8 * (i >> 2) + 4 * n + (i & 3); }
struct Unit { int pm, pn; };
struct Gemm { const bf16_t* A; const bf16_t* Bt; int M, N, K, lda, ldb, a_pn_off; };
struct StaticOrder {
    int nM, nN, nwg, G, c;
    __host__ __device__ void init(int M, int N, int G_, int c_) { nM = M / BM; nN = N / BM; nwg = nM * nN; G = G_; c = c_; }
    __host__ __device__ bool next(int i, Unit& u) const {
        const long L = (long)i * G + c; if (L >= nwg) return false;
        int wgid = (int)L; { const int q = nwg / NXCD, r = nwg % NXCD, xcd = wgid % NXCD, off = wgid / NXCD; wgid = (xcd < r ? xcd * (q + 1) : r * (q + 1) + (xcd - r) * q) + off; }
        const int nig = WGM * nN, gid = wgid / nig, fm = gid * WGM, gsz = (nM - fm) < WGM ? (nM - fm) : WGM;
        u.pm = fm + ((wgid % nig) % gsz); u.pn = (wgid % nig) / gsz; return true;
    }
};
template <class Epi>
__device__ __forceinline__ void gemm_phase(LAS unsigned char* lds, const Gemm g, const StaticOrder& S, const Epi& E) {
    const int tid = opaque_tid(), wid = __builtin_amdgcn_readfirstlane(tid >> 6), lane = tid & 63, wr = wid >> 2, wc = wid & 3, fr = lane & 15, fq = lane >> 4;
    const int K = g.K, nt = K / BK;
    unsigned voffA[2], voffB[2];
#pragma unroll
    for (int i = 0; i < 2; ++i) { int R, C; stage_rc(tid * 16 + i * 8192, R, C); const int Rb = (R & ~31) + perm32(R & 31);
        voffA[i] = (unsigned)(R * g.lda + C) * 2u; voffB[i] = (unsigned)(Rb * g.ldb + C) * 2u; }
    const size_t kstep = (size_t)(BK * 2);
    const size_t hstepA = (size_t)HALF * g.lda * 2, hstepB = (size_t)HALF * g.ldb * 2;
    const size_t tstepA = 2 * hstepA, tstepB = 2 * hstepB;
    const unsigned ldsw = (unsigned)wid * 1024u;
    const int aoff = lds_byte(wr * 64 + fr, fq * 8), boff = lds_byte(wc * 32 + fr, fq * 8);
#define PG8_SA(b, h) (((b) * 2 + (h)) * HTB)
#define PG8_SB(b, h) ((4 + (b) * 2 + (h)) * HTB)
#define PG8_STAGE(bufoff, gbase, voff) do { _Pragma("unroll") for (int _i = 0; _i < 2; ++_i) \
        __builtin_amdgcn_global_load_lds((const unsigned*)((const char*)(gbase) + (voff)[_i]), (LAS unsigned*)(lds + (bufoff) + ldsw + _i * 8192), 16, 0, 0); } while (0)
#define PG8_LDA(dst, b, h) do { _Pragma("unroll") for (int m = 0; m < 4; ++m) _Pragma("unroll") for (int k = 0; k < 2; ++k) dst[m][k] = *(const LAS bf16x8*)(lds + PG8_SA(b, h) + aoff + m * 2048 + k * 1024); } while (0)
#define PG8_LDB(dst, b, h) do { _Pragma("unroll") for (int n = 0; n < 2; ++n) _Pragma("unroll") for (int k = 0; k < 2; ++k) dst[n][k] = *(const LAS bf16x8*)(lds + PG8_SB(b, h) + boff + n * 2048 + k * 1024); } while (0)
#define PG8_MMA(ai, bj, At, Bt) do { __builtin_amdgcn_s_setprio(1); _Pragma("unroll") for (int m = 0; m < 4; ++m) _Pragma("unroll") for (int n = 0; n < 2; ++n) _Pragma("unroll") for (int k = 0; k < 2; ++k) \
        acc[ai][bj][m][n] = __builtin_amdgcn_mfma_f32_16x16x32_bf16(Bt[n][k], At[m][k], acc[ai][bj][m][n], 0, 0, 0); __builtin_amdgcn_s_setprio(0); } while (0)
#define PG8_WAIT_V(n) asm volatile("s_waitcnt vmcnt(" #n ")" ::: "memory")
#define PG8_WAIT_L(n) asm volatile("s_waitcnt lgkmcnt(" #n ")" ::: "memory")
#define PG8_BAR __builtin_amdgcn_s_barrier()
#define PG8_SCHED __builtin_amdgcn_sched_barrier(0)
    Unit cur, nxt; int ui = 0;
    if (!S.next(0, cur)) return;
    f32x4 acc[2][2][4][2];
#pragma unroll
    for (int a = 0; a < 2; ++a)
#pragma unroll
        for (int b = 0; b < 2; ++b)
#pragma unroll
            for (int m = 0; m < 4; ++m)
#pragma unroll
                for (int n = 0; n < 2; ++n) acc[a][b][m][n] = (f32x4){0.f, 0.f, 0.f, 0.f};
    bf16x8 At[4][2], B0[2][2], B1[2][2];
    const char* cA = (const char*)g.A + (size_t)cur.pm * tstepA + (size_t)cur.pn * g.a_pn_off * 2; const char* cB = (const char*)g.Bt + (size_t)cur.pn * tstepB;
    if constexpr (PG8_SP2) {
        PG8_STAGE(PG8_SB(0, 0), cB, voffB); PG8_STAGE(PG8_SB(0, 1), cB + hstepB, voffB); PG8_STAGE(PG8_SA(0, 0), cA, voffA); PG8_STAGE(PG8_SA(0, 1), cA + hstepA, voffA);
        if (wr == 1) PG8_BAR;
        PG8_WAIT_V(2); PG8_BAR;
        PG8_STAGE(PG8_SB(1, 0), cB + kstep, voffB); PG8_STAGE(PG8_SA(1, 0), cA + kstep, voffA); PG8_STAGE(PG8_SB(1, 1), cB + hstepB + kstep, voffB);
        PG8_WAIT_V(6); PG8_BAR;
    } else {
    PG8_STAGE(PG8_SB(0, 0), cB, voffB); PG8_STAGE(PG8_SA(0, 0), cA, voffA); PG8_STAGE(PG8_SB(0, 1), cB + hstepB, voffB); PG8_STAGE(PG8_SA(0, 1), cA + hstepA, voffA);
    if (wr == 1) PG8_BAR;
    PG8_WAIT_V(4); PG8_BAR;
    PG8_STAGE(PG8_SB(1, 0), cB + kstep, voffB); PG8_STAGE(PG8_SA(1, 0), cA + kstep, voffA); PG8_STAGE(PG8_SB(1, 1), cB + hstepB + kstep, voffB);
    PG8_WAIT_V(6); PG8_BAR;
    }
    for (;;) {
        const bool has_next = S.next(ui + 1, nxt);
        const char* nA = has_next ? (const char*)g.A + (size_t)nxt.pm * tstepA + (size_t)nxt.pn * g.a_pn_off * 2 : cA; const char* nB = has_next ? (const char*)g.Bt + (size_t)nxt.pn * tstepB : cB;
        for (int t = 0; t < nt; t += 2) {
            const bool last = (t == nt - 2);
            const char* a1 = cA + (size_t)(t + 1) * kstep;
            const char* a2 = last ? nA : cA + (size_t)(t + 2) * kstep; const char* b2 = last ? nB : cB + (size_t)(t + 2) * kstep;
            const char* a3 = a2 + kstep; const char* b3 = b2 + kstep;
            if constexpr (PG8_SP2) {
            PG8_LDB(B0, 0, 0); PG8_LDB(B1, 0, 1); PG8_SCHED; PG8_LDA(At, 0, 0); PG8_STAGE(PG8_SA(1, 1), a1 + hstepA, voffA);
            PG8_WAIT_V(8); PG8_WAIT_L(0); PG8_BAR; PG8_MMA(0, 0, At, B0); PG8_MMA(0, 1, At, B1); PG8_BAR; PG8_SCHED;
            PG8_LDA(At, 0, 1); PG8_STAGE(PG8_SB(0, 0), b2, voffB); PG8_STAGE(PG8_SB(0, 1), b2 + hstepB, voffB); PG8_STAGE(PG8_SA(0, 0), a2, voffA);
            PG8_WAIT_V(8); PG8_WAIT_L(0); PG8_BAR; PG8_MMA(1, 0, At, B0); PG8_MMA(1, 1, At, B1); PG8_BAR; PG8_SCHED;
            PG8_LDB(B0, 1, 0); PG8_LDB(B1, 1, 1); PG8_SCHED; PG8_LDA(At, 1, 0); PG8_STAGE(PG8_SA(0, 1), a2 + hstepA, voffA);
            PG8_WAIT_V(8); PG8_WAIT_L(0); PG8_BAR; PG8_MMA(0, 0, At, B0); PG8_MMA(0, 1, At, B1); PG8_BAR; PG8_SCHED;
            PG8_LDA(At, 1, 1); PG8_STAGE(PG8_SB(1, 0), b3, voffB); PG8_STAGE(PG8_SB(1, 1), b3 + hstepB, voffB); PG8_STAGE(PG8_SA(1, 0), a3, voffA);
            PG8_WAIT_V(8); PG8_WAIT_L(0); PG8_BAR; PG8_MMA(1, 0, At, B0); PG8_MMA(1, 1, At, B1); PG8_BAR; PG8_SCHED;
            } else {
            PG8_LDB(B0, 0, 0); PG8_SCHED; PG8_LDA(At, 0, 0); PG8_STAGE(PG8_SA(1, 1), a1 + hstepA, voffA);
            PG8_WAIT_L(8); PG8_BAR; PG8_WAIT_L(0); PG8_MMA(0, 0, At, B0); PG8_BAR; PG8_SCHED;
            PG8_LDB(B1, 0, 1); PG8_STAGE(PG8_SB(0, 0), b2, voffB);
            PG8_BAR; PG8_WAIT_L(0); PG8_MMA(0, 1, At, B1); PG8_BAR;
            PG8_LDA(At, 0, 1); PG8_STAGE(PG8_SA(0, 0), a2, voffA);
            PG8_BAR; PG8_WAIT_L(0); PG8_MMA(1, 0, At, B0); PG8_BAR; PG8_SCHED;
            PG8_STAGE(PG8_SB(0, 1), b2 + hstepB, voffB);
            PG8_WAIT_V(6); PG8_BAR; PG8_MMA(1, 1, At, B1); PG8_BAR;
            PG8_LDB(B0, 1, 0); PG8_SCHED; PG8_LDA(At, 1, 0); PG8_STAGE(PG8_SA(0, 1), a2 + hstepA, voffA);
            PG8_WAIT_L(8); PG8_BAR; PG8_WAIT_L(0); PG8_MMA(0, 0, At, B0); PG8_BAR; PG8_SCHED;
            PG8_LDB(B1, 1, 1); PG8_STAGE(PG8_SB(1, 0), b3, voffB);
            PG8_BAR; PG8_WAIT_L(0); PG8_MMA(0, 1, At, B1); PG8_BAR;
            PG8_LDA(At, 1, 1); PG8_STAGE(PG8_SA(1, 0), a3, voffA);
            PG8_BAR; PG8_WAIT_L(0); PG8_MMA(1, 0, At, B0); PG8_BAR; PG8_SCHED;
            PG8_STAGE(PG8_SB(1, 1), b3 + hstepB, voffB);
            PG8_WAIT_V(6); PG8_BAR; PG8_MMA(1, 1, At, B1); PG8_BAR;
            }
        }
        if (wr == 0) PG8_BAR;
        E(acc, cur, wr, wc, fr, fq);
        if (!has_next) break;
#pragma unroll
        for (int a = 0; a < 2; ++a)
#pragma unroll
            for (int b = 0; b < 2; ++b)
#pragma unroll
                for (int m = 0; m < 4; ++m)
#pragma unroll
                    for (int n = 0; n < 2; ++n) acc[a][b][m][n] = (f32x4){0.f, 0.f, 0.f, 0.f};
        cur = nxt; cA = nA; cB = nB; ++ui;
        if (wr == 1) PG8_BAR;
    }
    PG8_WAIT_V(0);
    PG8_BAR;
#undef PG8_SA
#undef PG8_SB
#undef PG8_STAGE
#undef PG8_LDA
#undef PG8_LDB
#undef PG8_MMA
#undef PG8_WAIT_V
#undef PG8_WAIT_L
#undef PG8_BAR
#undef PG8_SCHED
}
}

template <int MODE> struct Epi {
    bf16_t* O; int ldc; const float* vec; const bf16_t* aux; int ldaux; float* stats;
    __device__ __forceinline__ void operator()(const f32x4 (&acc)[2][2][4][2], const pg8::Unit& u, int wr, int wc, int fr, int fq) const {
        using namespace pg8;
        const int row0 = u.pm * BM + wr * 64 + fr, col0 = u.pn * BM + wc * 32 + 8 * fq;
        int act = 0;
        if (MODE == 0) { const int t = u.pn; act = ((t >= 4 && t < 8) || (t >= 24 && t < 28) || t >= 40) ? 1 : ((t >= 20 && t < 24) ? 2 : ((t >= 8 && t < 12) ? 3 : 0)); }
#pragma unroll
        for (int ai = 0; ai < 2; ++ai)
#pragma unroll
            for (int m = 0; m < 4; ++m) {
                const int row = row0 + ai * HALF + m * 16;
                bf16_t* rowp = O + (size_t)row * ldc + col0;
                float ss = 0.f;
#pragma unroll
                for (int bj = 0; bj < 2; ++bj) {
                    f32x4 v0 = acc[ai][bj][m][0], v1 = acc[ai][bj][m][1];
                    if (MODE == 0) {
                        if (act == 1) {
#pragma unroll
                            for (int j = 0; j < 4; ++j) { v0[j] = siluf_(v0[j]); v1[j] = siluf_(v1[j]); }
                        } else if (act == 2) {
#pragma unroll
                            for (int j = 0; j < 4; ++j) { v0[j] = sigmoidf_(v0[j]); v1[j] = sigmoidf_(v1[j]); }
                        } else if (act == 3) { v0 = v0 * 0.0625f; v1 = v1 * 0.0625f; }
                    }
                    if (MODE == 1) {
                        const u32x4 z = *(const u32x4*)(aux + (size_t)row * ldaux + col0 + bj * HALF);
                        v0 = v0 * *(const f32x4*)(vec + col0 + bj * HALF); v1 = v1 * *(const f32x4*)(vec + col0 + bj * HALF + 4);
                        v0[0] *= bflo(z.x); v0[1] *= bfhi(z.x); v0[2] *= bflo(z.y); v0[3] *= bfhi(z.y);
                        v1[0] *= bflo(z.z); v1[1] *= bfhi(z.z); v1[2] *= bflo(z.w); v1[3] *= bfhi(z.w);
                    }
                    if (MODE == 4) {
                        const u32x4 z = *(const u32x4*)(aux + (size_t)row * ldaux + col0 + bj * HALF);
#pragma unroll
                        for (int j = 0; j < 4; ++j) { v0[j] = sigmoidf_(v0[j]); v1[j] = sigmoidf_(v1[j]); }
                        v0[0] *= bflo(z.x); v0[1] *= bfhi(z.x); v0[2] *= bflo(z.y); v0[3] *= bfhi(z.y);
                        v1[0] *= bflo(z.z); v1[1] *= bfhi(z.z); v1[2] *= bflo(z.w); v1[3] *= bfhi(z.w);
                    }
                    if (MODE == 3 || MODE == 4) ss += (v0[0] * v0[0] + v0[1] * v0[1]) + (v0[2] * v0[2] + v0[3] * v0[3]) + (v1[0] * v1[0] + v1[1] * v1[1]) + (v1[2] * v1[2] + v1[3] * v1[3]);
                    u32x4 w; w.x = cvt_pk_bf16(v0[0], v0[1]); w.y = cvt_pk_bf16(v0[2], v0[3]); w.z = cvt_pk_bf16(v1[0], v1[1]); w.w = cvt_pk_bf16(v1[2], v1[3]);
                    *(u32x4*)(rowp + bj * HALF) = w;
                }
                if (MODE == 3 || MODE == 4) {
                    ss = addx<16>(ss); ss = addx<32>(ss);
                    if (fq == 0) stats[(size_t)row * 64 + u.pn * 4 + wc] = ss;
                }
            }
    }
};

namespace att {
constexpr int D = 128, NW = 8, QBLK = 32, KVBLK = 64;
constexpr float SCALE = 0.088388347648318440f;
constexpr float THR = 8.f;
constexpr int LDQ = NIN, LDK = 128, LDV = NIN;
constexpr size_t SHM_V = KVBLK * D * 2, SHM_K = KVBLK * D * 2;
#define KSWZ(row, colB) ((row) * 256 + ((colB) ^ (((row) & 7) << 4)))
__device__ __forceinline__ int crow(int r, int hi) { return (r & 3) + 8 * (r >> 2) + 4 * hi; }
constexpr float THRL = THR * 1.4426950408889634f;
__device__ __forceinline__ void partialSM(f32x16& p0, f32x16& p1, float& m_reg, float& mn, float& alpha, bool noshift) {
  if (noshift) alpha = 1.f;
  else {
  float pmax = p0[0]; for (int r = 1; r < 16; ++r) pmax = fmaxf(pmax, p0[r]); for (int r = 0; r < 16; ++r) pmax = fmaxf(pmax, p1[r]);
  { auto rr = __builtin_amdgcn_permlane32_swap(__float_as_uint(pmax), __float_as_uint(pmax), false, false);
    pmax = fmaxf(__uint_as_float(rr[0]), __uint_as_float(rr[1])); }
  if (__builtin_expect(__all(pmax - m_reg <= THRL), 1)) { mn = m_reg; alpha = 1.f; }
  else { mn = fmaxf(m_reg, pmax); alpha = __builtin_amdgcn_exp2f(m_reg - mn); m_reg = mn; }
  for (int r = 0; r < 16; ++r) p0[r] -= mn; for (int r = 0; r < 16; ++r) p1[r] -= mn;
  }
  for (int r = 0; r < 16; ++r) p0[r] = __builtin_amdgcn_exp2f(p0[r]);
}
__device__ __forceinline__ void finishSM(f32x16& p0, f32x16& p1, float alpha, float& l_reg, bf16x8& pa0, bf16x8& pa1, bf16x8& pa2, bf16x8& pa3) {
  for (int r = 0; r < 16; ++r) p1[r] = __builtin_amdgcn_exp2f(p1[r]);
  float ps = 0; for (int r = 0; r < 16; ++r) ps += p0[r]; for (int r = 0; r < 16; ++r) ps += p1[r];
  { auto rr = __builtin_amdgcn_permlane32_swap(__float_as_uint(ps), __float_as_uint(ps), false, false);
    ps = __uint_as_float(rr[0]) + __uint_as_float(rr[1]); }
  l_reg = l_reg * alpha + ps;
#define PK4(P, BASE, OUT) do { unsigned a0 = cvt_pk_bf16(P[BASE + 0], P[BASE + 1]), a1 = cvt_pk_bf16(P[BASE + 2], P[BASE + 3]);   \
    unsigned b0 = cvt_pk_bf16(P[BASE + 4], P[BASE + 5]), b1 = cvt_pk_bf16(P[BASE + 6], P[BASE + 7]);                              \
    u32x4 w = {a0, a1, b0, b1}; OUT = *reinterpret_cast<bf16x8*>(&w); } while (0)
  PK4(p0, 0, pa0); PK4(p0, 8, pa1); PK4(p1, 0, pa2); PK4(p1, 8, pa3);
#undef PK4
}
__device__ __forceinline__ void qkt(f32x16& p0, f32x16& p1, const bf16_t* Ks, const bf16x8* qr, int r32, int hi) {
  p0 = f32x16{}; p1 = f32x16{};
  for (int d0 = 0; d0 < 8; ++d0) { int cb = (d0 * 16 + hi * 8) * 2;
    bf16x8 b0 = *reinterpret_cast<const bf16x8*>((const char*)Ks + KSWZ(r32, cb));
    bf16x8 b1 = *reinterpret_cast<const bf16x8*>((const char*)Ks + KSWZ(32 + r32, cb));
    p0 = __builtin_amdgcn_mfma_f32_32x32x16_bf16(b0, qr[d0], p0, 0, 0, 0);
    p1 = __builtin_amdgcn_mfma_f32_32x32x16_bf16(b1, qr[d0], p1, 0, 0, 0); }
}
__device__ __forceinline__ int v_st(int k, int c) { const int kk = (k & ~0xC) | ((k & 4) << 1) | ((k & 8) >> 1); return ((kk >> 3) * 4 + (c >> 5)) * 512 + ((kk & 7) * 32 + (c & 31)) * 2; }
__device__ __forceinline__ int v_rd_base(int lane) { return ((lane & 3) << 3) | (((lane >> 2) & 3) << 6) | (((lane >> 4) & 1) << 5) | (((lane >> 5) & 1) << 8); }
constexpr int v_rd_off(int d0, int ks, int half) { return d0 * 512 + ks * 4096 + half * 2048; }
template <int OFF> __device__ __forceinline__ s16x4 tr_read(int vb) {
  s16x4 r; asm volatile("ds_read_b64_tr_b16 %0, %1 offset:%2" : "=&v"(r) : "v"(vb), "i"(OFF) : "memory"); return r;
}
template <int D0> __device__ __forceinline__ void pv_issue(s16x4 (&r)[8], int vb) {
  r[0] = tr_read<v_rd_off(D0, 0, 0)>(vb); r[1] = tr_read<v_rd_off(D0, 0, 1)>(vb); r[2] = tr_read<v_rd_off(D0, 1, 0)>(vb); r[3] = tr_read<v_rd_off(D0, 1, 1)>(vb);
  r[4] = tr_read<v_rd_off(D0, 2, 0)>(vb); r[5] = tr_read<v_rd_off(D0, 2, 1)>(vb); r[6] = tr_read<v_rd_off(D0, 3, 0)>(vb); r[7] = tr_read<v_rd_off(D0, 3, 1)>(vb);
}
__device__ __forceinline__ void pv_mma(f32x16& od, const s16x4 (&r)[8], bf16x8 pa0, bf16x8 pa1, bf16x8 pa2, bf16x8 pa3) {
#define PK(L, H) (bf16x8){L[0], L[1], L[2], L[3], H[0], H[1], H[2], H[3]}
  od = __builtin_amdgcn_mfma_f32_32x32x16_bf16(pa0, PK(r[0], r[1]), od, 0, 0, 0);
  od = __builtin_amdgcn_mfma_f32_32x32x16_bf16(pa1, PK(r[2], r[3]), od, 0, 0, 0);
  od = __builtin_amdgcn_mfma_f32_32x32x16_bf16(pa2, PK(r[4], r[5]), od, 0, 0, 0);
  od = __builtin_amdgcn_mfma_f32_32x32x16_bf16(pa3, PK(r[6], r[7]), od, 0, 0, 0);
#undef PK
}
__device__ __forceinline__ void pv_d0(f32x16* o, int vb, bf16x8 pa0, bf16x8 pa1, bf16x8 pa2, bf16x8 pa3) {
  s16x4 ra[8], rb[8];
  pv_issue<0>(ra, vb); pv_issue<1>(rb, vb);
  asm volatile("s_waitcnt lgkmcnt(8)" ::: "memory"); SBAR(); pv_mma(o[0], ra, pa0, pa1, pa2, pa3); SBAR();
  pv_issue<2>(ra, vb);
  asm volatile("s_waitcnt lgkmcnt(8)" ::: "memory"); SBAR(); pv_mma(o[1], rb, pa0, pa1, pa2, pa3); SBAR();
  pv_issue<3>(rb, vb);
  asm volatile("s_waitcnt lgkmcnt(8)" ::: "memory"); SBAR(); pv_mma(o[2], ra, pa0, pa1, pa2, pa3); SBAR();
  asm volatile("s_waitcnt lgkmcnt(0)" ::: "memory"); SBAR(); pv_mma(o[3], rb, pa0, pa1, pa2, pa3);
}
template <bool NOSHIFT>
__device__ __forceinline__ void attn_unit(const bf16_t* __restrict__ Qb, const bf16_t* __restrict__ Kh, const bf16_t* __restrict__ Vh,
                                          const bf16_t* __restrict__ Zb, bf16_t* __restrict__ Yb, int seq, char* lds, LAS unsigned char* ldsl) {
  const int tid = opaque_tid();
  const int wid = tid >> 6, lane = tid & 63, r32 = lane & 31, hi = lane >> 5, wu = __builtin_amdgcn_readfirstlane(wid);
  char* V_lds = lds; char* K_lds = lds + 4 * SHM_V;
  float* ws = (float*)(lds + 4 * SHM_V + 4 * SHM_K) + wid * 64; float* li_l = ws; float* al_l = ws + 32;
  float m_reg = -1e30f, l_reg = 0; f32x16 o[4] = {}; bf16x8 qr[8];
  const bf16_t* Qw = Qb + (long)(wid * QBLK + r32) * LDQ + hi * 8;
#pragma unroll
  for (int d0 = 0; d0 < 8; ++d0) qr[d0] = *reinterpret_cast<const bf16x8*>(Qw + d0 * 16);
  const int vb0 = (int)(uintptr_t)V_lds + v_rd_base(lane);
  unsigned kgo0, kgo1, vgo0;
  { const int p = lane & 15, ra = 8 * wu + (lane >> 4), rb = ra + 4;
    kgo0 = (unsigned)(ra * LDK * 2 + ((p ^ (ra & 7)) << 4)); kgo1 = (unsigned)(rb * LDK * 2 + ((p ^ (rb & 7)) << 4));
    const int kk = 8 * wu + ((lane & 31) >> 2), k = kk;
    vgo0 = (unsigned)((k * LDV + 32 * (lane >> 5) + 8 * (lane & 3)) * 2); }
#define ADMA(t) do { const int b_ = (t) & 3; const char* kp_ = (const char*)Kh + (size_t)(t) * (KVBLK * LDK * 2); const char* vp_ = (const char*)Vh + (size_t)(t) * ((size_t)KVBLK * LDV * 2); \
    LAS unsigned char* kd_ = ldsl + 4 * SHM_V + b_ * SHM_K + wu * 2048; LAS unsigned char* vd_ = ldsl + b_ * SHM_V + wu * 2048; \
    __builtin_amdgcn_global_load_lds((const unsigned*)(kp_ + kgo0), (LAS unsigned*)kd_, 16, 0, 0); \
    __builtin_amdgcn_global_load_lds((const unsigned*)(kp_ + kgo1), (LAS unsigned*)(kd_ + 1024), 16, 0, 0); \
    __builtin_amdgcn_global_load_lds((const unsigned*)(vp_ + vgo0), (LAS unsigned*)vd_, 16, 0, 0); \
    __builtin_amdgcn_global_load_lds((const unsigned*)(vp_ + vgo0 + 128), (LAS unsigned*)(vd_ + 1024), 16, 0, 0); } while (0)
#define AWAIT4() asm volatile("s_waitcnt vmcnt(4)" ::: "memory")
#define AWAIT0() asm volatile("s_waitcnt vmcnt(0)" ::: "memory")
#define KBUF(t) ((bf16_t*)(K_lds + ((t) & 3) * SHM_K))
#define VBUF(t) (vb0 + ((t) & 3) * (int)SHM_V)
#define RESC(a) do { if (!NOSHIFT && __any((a) < 1.f)) { if (hi == 0) al_l[r32] = (a); asm volatile("s_waitcnt lgkmcnt(0)" ::: "memory"); \
    for (int d = 0; d < 4; ++d) for (int r = 0; r < 16; ++r) o[d][r] *= al_l[crow(r, hi)]; } } while (0)
  f32x16 pA0, pA1, pB0, pB1; float mnA, mnB, alA, alB; bf16x8 pa0, pa1, pa2, pa3; const int NT = seq / KVBLK;
  constexpr bool fixs = NOSHIFT;
  ADMA(0); ADMA(1);
  AWAIT4(); __syncthreads();
  qkt(pA0, pA1, KBUF(0), qr, r32, hi); partialSM(pA0, pA1, m_reg, mnA, alA, fixs);
  ADMA(2);
  AWAIT4(); __syncthreads();
  for (int j = 1; j + 1 < NT; j += 2) {
    SBAR(); qkt(pB0, pB1, KBUF(j), qr, r32, hi);
    finishSM(pA0, pA1, alA, l_reg, pa0, pa1, pa2, pa3); SBAR();
    ADMA(j + 2); SBAR();
    pv_d0(o, VBUF(j - 1), pa0, pa1, pa2, pa3); partialSM(pB0, pB1, m_reg, mnB, alB, fixs);
    AWAIT4();
    RESC(alB); __syncthreads();
    SBAR(); qkt(pA0, pA1, KBUF(j + 1), qr, r32, hi);
    finishSM(pB0, pB1, alB, l_reg, pa0, pa1, pa2, pa3); SBAR();
    if (j + 3 < NT) { ADMA(j + 3); } SBAR();
    pv_d0(o, VBUF(j), pa0, pa1, pa2, pa3); partialSM(pA0, pA1, m_reg, mnA, alA, fixs);
    if (j + 3 < NT) AWAIT4(); else AWAIT0();
    RESC(alA); __syncthreads();
  }
  SBAR(); qkt(pB0, pB1, KBUF(NT - 1), qr, r32, hi);
  finishSM(pA0, pA1, alA, l_reg, pa0, pa1, pa2, pa3); SBAR();
  pv_d0(o, VBUF(NT - 2), pa0, pa1, pa2, pa3); partialSM(pB0, pB1, m_reg, mnB, alB, fixs);
  __syncthreads(); RESC(alB);
  finishSM(pB0, pB1, alB, l_reg, pa0, pa1, pa2, pa3); SBAR();
  const bf16_t* Zw = Zb + (long)(wid * QBLK) * NIN; bf16_t* Yw = Yb + (long)(wid * QBLK) * DM;
  u32x4 zg[8];
#pragma unroll
  for (int e = 0; e < 8; ++e) { const int idx = lane + 64 * e, row = idx >> 4, ch = idx & 15; zg[e] = *(const u32x4*)(Zw + (long)row * NIN + ch * 8); }
  SBAR();
  pv_d0(o, VBUF(NT - 1), pa0, pa1, pa2, pa3);
  if (hi == 0) li_l[r32] = l_reg; asm volatile("s_waitcnt lgkmcnt(0)" ::: "memory");
  float rli[16];
#pragma unroll
  for (int r = 0; r < 16; ++r) rli[r] = __builtin_amdgcn_rcpf(li_l[crow(r, hi)]);
  char* Ol = K_lds + wid * 8192;
#pragma unroll
  for (int r = 0; r < 16; ++r) { const int orow = crow(r, hi);
#pragma unroll
    for (int d0 = 0; d0 < 4; ++d0) *(bf16_t*)(Ol + orow * 256 + (d0 * 32 + r32) * 2) = f2bf(o[d0][r] * rli[r]); }
  asm volatile("s_waitcnt lgkmcnt(0)" ::: "memory");
#pragma unroll
  for (int e = 0; e < 8; ++e) { const int idx = lane + 64 * e, row = idx >> 4, ch = idx & 15;
    const u32x4 ov = *(const u32x4*)(Ol + row * 256 + ch * 16); const u32x4 z = zg[e];
    u32x4 y; y.x = cvt_pk_bf16(bflo(ov.x) * bflo(z.x), bfhi(ov.x) * bfhi(z.x)); y.y = cvt_pk_bf16(bflo(ov.y) * bflo(z.y), bfhi(ov.y) * bfhi(z.y));
    y.z = cvt_pk_bf16(bflo(ov.z) * bflo(z.z), bfhi(ov.z) * bfhi(z.z)); y.w = cvt_pk_bf16(bflo(ov.w) * bflo(z.w), bfhi(ov.w) * bfhi(z.w));
    *(u32x4*)(Yw + (long)row * DM + ch * 8) = y; }
  __syncthreads();
#undef ADMA
#undef AWAIT4
#undef AWAIT0
#undef KBUF
#undef VBUF
#undef RESC
}
}

namespace ml {
constexpr int ML_K0 = 0, ML_K1 = 16384, ML_V = 32768, ML_VW = 49152, ML_Q0 = 65536, ML_Q1 = 81920, ML_S = 98304, ML_N = 106496, ML_QN = 107520, ML_DP = 107776, ML_TAB = 108288;
__device__ __forceinline__ unsigned offb(unsigned row, unsigned ch) { return 256u * row + 16u * (ch ^ (((row & 3) << 2) | ((row >> 2) & 3))); }
template <int IMM> __device__ __forceinline__ s16x4 trr(unsigned addr) { s16x4 r; asm volatile("ds_read_b64_tr_b16 %0, %1 offset:%2" : "=&v"(r) : "v"(addr), "i"(IMM) : "memory"); return r; }
#define ML_PK(L, H) (bf16x8){L[0], L[1], L[2], L[3], H[0], H[1], H[2], H[3]}
__host__ __device__ constexpr unsigned trc(int c, int ks, int t) { return 8192u * ks + 1024u * t + 16u * ((((unsigned)c >> 1) << 2) | (((unsigned)c & 1) << 1) | (unsigned)t); }
__device__ __forceinline__ float scan_add(float v, int lane) {
    int l = lane; asm volatile("" : "+v"(l));
#pragma unroll
    for (int o = 1; o < 64; o <<= 1) { const float t = shfl_from(v, l - o); if (l >= o) v += t; }
    return v;
}
__device__ __forceinline__ float scan_max(float v, int lane) {
    int l = lane; asm volatile("" : "+v"(l));
#pragma unroll
    for (int o = 1; o < 64; o <<= 1) { const float t = shfl_from(v, l - o); if (l >= o) v = fmaxf(v, t); }
    return v;
}
struct KF { s16x4 a00, a01, a10, a11, b00, b01, b10, b11; };
template <int KIMG, int C0> __device__ __forceinline__ void kf_issue(KF& f, unsigned tb) {
    f.a00 = trr<KIMG>(tb ^ trc(C0, 0, 0)); f.a01 = trr<KIMG>(tb ^ trc(C0, 0, 1)); f.a10 = trr<KIMG>(tb ^ trc(C0, 1, 0)); f.a11 = trr<KIMG>(tb ^ trc(C0, 1, 1));
    f.b00 = trr<KIMG>(tb ^ trc(C0 + 1, 0, 0)); f.b01 = trr<KIMG>(tb ^ trc(C0 + 1, 0, 1)); f.b10 = trr<KIMG>(tb ^ trc(C0 + 1, 1, 0)); f.b11 = trr<KIMG>(tb ^ trc(C0 + 1, 1, 1));
}
__device__ __forceinline__ void kf_mma(f32x4& Ca, f32x4& Cb, const KF& f, const bf16x8 wb0, const bf16x8 wb1) {
    Ca = __builtin_amdgcn_mfma_f32_16x16x32_bf16(ML_PK(f.a00, f.a01), wb0, Ca, 0, 0, 0);
    Cb = __builtin_amdgcn_mfma_f32_16x16x32_bf16(ML_PK(f.b00, f.b01), wb0, Cb, 0, 0, 0);
    Ca = __builtin_amdgcn_mfma_f32_16x16x32_bf16(ML_PK(f.a10, f.a11), wb1, Ca, 0, 0, 0);
    Cb = __builtin_amdgcn_mfma_f32_16x16x32_bf16(ML_PK(f.b10, f.b11), wb1, Cb, 0, 0, 0);
}
#define ML_WAITL(n) asm volatile("s_waitcnt lgkmcnt(" #n ")" ::: "memory")
__device__ __forceinline__ void mlstm_item(LAS unsigned char* lds, const bf16_t* __restrict__ zin, const float* __restrict__ gsc, const float* __restrict__ chs, bf16_t* __restrict__ hout,
                                           int seqrow, int seqlen, int head, int dir, int dvh) {
    const int tid = opaque_tid();
    const int lane = tid & 63, w = __builtin_amdgcn_readfirstlane(tid >> 6), g = lane >> 4, l15 = lane & 15;
    const unsigned lb = (unsigned)(uintptr_t)lds;
    const int NC = seqlen / 64;
    LAS float* tab = (LAS float*)(lds + ML_TAB + w * 1280);
    LAS float* nst = (LAS float*)(lds + ML_N);
    LAS float* qn = (LAS float*)(lds + ML_QN);
    LAS float* dp = (LAS float*)(lds + ML_DP);
    const unsigned Fh = l15 & 3, Fl = (l15 >> 2) & 3, q4 = l15 >> 2, p4 = lane & 3;
    unsigned rrb = 256u * l15 + 64u * Fh + 16u * (g ^ Fl);
    unsigned qrb = 256u * l15 + 64u * Fh + 16u * ((g >> 1) ^ Fl) + 8u * (g & 1);
    unsigned trb = lb + 256u * (8u * g + q4) + 16u * ((q4 << 2) | ((g & 1) << 1) | (p4 >> 1)) + 8u * (p4 & 1);
    unsigned srb = 128u * l15 + 16u * (g ^ ((l15 >> 1) & 7));
    f32x4 C[16];
#pragma unroll
    for (int t = 0; t < 16; ++t) C[t] = (f32x4){0.f, 0.f, 0.f, 0.f};
    float m = 0.f, decay = 1.f;
    if (tid < 256) nst[tid] = 0.f;
    u32x4 sq[4], sk[4], sv[2]; f32x4 gs; f32x2 cs2;
    const bf16_t* zq = zin + (size_t)seqrow * NIN + C_MQ + head * 256;
    const bf16_t* zk = zin + (size_t)seqrow * NIN + C_MK + head * 256;
    const bf16_t* zv = zin + (size_t)seqrow * NIN + C_MV + head * 256 + dvh * 128;
    const float* gsb = gsc + ((size_t)dir * NTOK + seqrow) * 16 + head * 4;
    const float* chb = chs + ((size_t)dir * 512 + (seqrow >> 6)) * 8 + head * 2 + (tid >> 10);
#define ML_LOAD(c) do { const int cc_ = dir ? NC - 1 - (c) : (c); const int t0_ = cc_ * 64;                                    \
        _Pragma("unroll") for (int e = 0; e < 4; ++e) { const int idx = tid + 512 * e, row = idx >> 5, ch = idx & 31; const int tok = dir ? t0_ + 63 - row : t0_ + row; \
            sq[e] = *(const u32x4*)(zq + (size_t)tok * NIN + ch * 8); sk[e] = *(const u32x4*)(zk + (size_t)tok * NIN + ch * 8); }      \
        _Pragma("unroll") for (int e = 0; e < 2; ++e) { const int idx = tid + 512 * e, row = idx >> 4, ch = idx & 15; const int tok = dir ? t0_ + 63 - row : t0_ + row; \
            sv[e] = *(const u32x4*)(zv + (size_t)tok * NIN + ch * 8); }                                                      \
        { const int tok = dir ? t0_ + 63 - lane : t0_ + lane; gs = *(const f32x4*)(gsb + (size_t)tok * 16); cs2 = *(const f32x2*)(chb + (size_t)cc_ * 8); } } while (0)
#define ML_SCALARS() do { const float A_ = fmaxf(m, gs[1]); const float A63_ = fmaxf(m, cs2[1]);                               \
        tab[lane] = gs[0]; tab[64 + lane] = A_; tab[128 + lane] = fast_exp(m - A_); tab[192 + lane] = fast_exp(-(gs[2] + A_)); tab[256 + lane] = fast_exp(gs[0] - A63_); \
        decay = fast_exp(m - A63_); m = cs2[0] + A63_; LDS_WAIT(); } while (0)
#define ML_STAGE() do {                                                                                                     \
        _Pragma("unroll") for (int e = 0; e < 4; ++e) { const int idx = tid + 512 * e, row = idx >> 5, ch = idx & 31;          \
            *(LAS u32x4*)(lds + ((ch >> 4) ? ML_Q1 : ML_Q0) + offb(row, ch & 15)) = sq[e]; *(LAS u32x4*)(lds + ((ch >> 4) ? ML_K1 : ML_K0) + offb(row, ch & 15)) = sk[e]; } \
        _Pragma("unroll") for (int e = 0; e < 2; ++e) { const int idx = tid + 512 * e, row = idx >> 4, ch = idx & 15; const float wk_ = tab[256 + row]; \
            *(LAS u32x4*)(lds + ML_V + offb(row, ch)) = sv[e]; u32x4 x = sv[e], y;                                             \
            y.x = cvt_pk_bf16(bflo(x.x) * wk_, bfhi(x.x) * wk_); y.y = cvt_pk_bf16(bflo(x.y) * wk_, bfhi(x.y) * wk_);          \
            y.z = cvt_pk_bf16(bflo(x.z) * wk_, bfhi(x.z) * wk_); y.w = cvt_pk_bf16(bflo(x.w) * wk_, bfhi(x.w) * wk_);          \
            *(LAS u32x4*)(lds + ML_VW + offb(row, ch)) = y; } } while (0)
    ML_LOAD(0);
    ML_SCALARS();
    ML_STAGE();
    __syncthreads();
    for (int c = 0; c < NC; ++c) {
        const int cc = dir ? NC - 1 - c : c, t0 = cc * 64;
        const float decay_c = decay;
        asm volatile("" : "+v"(rrb), "+v"(qrb), "+v"(trb), "+v"(srb));
        int opq_ = tid; asm volatile("" : "+v"(opq_));
        const int tid = opq_, lane = tid & 63, g = lane >> 4, l15 = lane & 15;
        {
            const int it = w >> 1, jt0 = (w & 1) * 2;
            f32x4 s0 = (f32x4){0.f, 0.f, 0.f, 0.f}, s1 = s0;
            bf16x8 kf0[4], kf1[4], qf[4];
#define ML_S1LOAD(s, b) do { const int qo = ((s) >> 2) ? ML_Q1 : ML_Q0, ko = ((s) >> 2) ? ML_K1 : ML_K0; const unsigned ra = rrb ^ (64u * ((s) & 3));   \
                kf0[b] = *(const LAS bf16x8*)(lds + ko + 4096 * jt0 + ra); kf1[b] = *(const LAS bf16x8*)(lds + ko + 4096 * jt0 + 4096 + ra); qf[b] = *(const LAS bf16x8*)(lds + qo + 4096 * it + ra); } while (0)
            ML_S1LOAD(0, 0); ML_S1LOAD(1, 1); ML_S1LOAD(2, 2);
#pragma unroll
            for (int s = 0; s < 8; ++s) {
                if (s < 5) ML_S1LOAD(s + 3, (s + 3) & 3);
                s0 = __builtin_amdgcn_mfma_f32_16x16x32_bf16(kf0[s & 3], qf[s & 3], s0, 0, 0, 0);
                s1 = __builtin_amdgcn_mfma_f32_16x16x32_bf16(kf1[s & 3], qf[s & 3], s1, 0, 0, 0);
            }
#undef ML_S1LOAD
            const int il = 16 * it + l15;
            const float Ai = tab[64 + il];
            float ps = 0.f;
#pragma unroll
            for (int tt = 0; tt < 2; ++tt) {
                const int jt = jt0 + tt, j0 = 16 * jt + 4 * g;
                const f32x4 av = *(const LAS f32x4*)(tab + j0);
                const f32x4 sx = tt ? s1 : s0;
                float sw[4];
#pragma unroll
                for (int r = 0; r < 4; ++r) { const float wgt = (j0 + r <= il) ? fast_exp(av[r] - Ai) : 0.f; sw[r] = sx[r] * wgt; ps += sw[r]; }
                u32x2 pk; pk.x = cvt_pk_bf16(sw[0], sw[1]); pk.y = cvt_pk_bf16(sw[2], sw[3]);
                *(LAS u32x2*)(lds + ML_S + il * 128 + (((2 * jt + (g >> 1)) ^ ((il >> 1) & 7)) << 4) + (g & 1) * 8) = pk;
            }
            ps = addx<16>(ps); ps = addx<32>(ps);
            if (g == 0) dp[il * 2 + (w & 1)] = ps;
        }
        {
            const int i = tid >> 3, sl = tid & 7;
            const unsigned qb0 = offb(i, 4 * (sl & 3));
            float a = 0.f;
#pragma unroll
            for (int cch = 0; cch < 4; ++cch) {
                const u32x4 x = *(const LAS u32x4*)(lds + ((sl >> 2) ? ML_Q1 : ML_Q0) + (qb0 ^ (16u * cch)));
                const f32x4 n0 = *(const LAS f32x4*)(nst + 32 * sl + 8 * cch), n1 = *(const LAS f32x4*)(nst + 32 * sl + 8 * cch + 4);
                a += bflo(x.x) * n0[0] + bfhi(x.x) * n0[1] + bflo(x.y) * n0[2] + bfhi(x.y) * n0[3] + bflo(x.z) * n1[0] + bfhi(x.z) * n1[1] + bflo(x.w) * n1[2] + bfhi(x.w) * n1[3];
            }
            a = addx<1>(a); a = addx<2>(a); a = addx<4>(a);
            if (sl == 0) qn[i] = a;
        }
        __syncthreads();
        const unsigned tbw = trb ^ trc(w, 0, 0);
        {
            f32x4 a1[4], a2[4];
#pragma unroll
            for (int t = 0; t < 4; ++t) { a1[t] = (f32x4){0.f, 0.f, 0.f, 0.f}; a2[t] = a1[t]; }
            {
                const s16x4 v00 = trr<ML_V>(tbw ^ trc(0, 0, 0)), v01 = trr<ML_V>(tbw ^ trc(0, 0, 1)), v10 = trr<ML_V>(tbw ^ trc(0, 1, 0)), v11 = trr<ML_V>(tbw ^ trc(0, 1, 1));
                bf16x8 sa[2][4];
#pragma unroll
                for (int ks = 0; ks < 2; ++ks)
#pragma unroll
                    for (int t = 0; t < 4; ++t) sa[ks][t] = *(const LAS bf16x8*)(lds + ML_S + 2048 * t + (srb ^ (64u * ks)));
                LDS_WAIT(); SBAR();
                const bf16x8 vb0 = ML_PK(v00, v01), vb1 = ML_PK(v10, v11);
#pragma unroll
                for (int t = 0; t < 4; ++t) { a1[t] = __builtin_amdgcn_mfma_f32_16x16x32_bf16(sa[0][t], vb0, a1[t], 0, 0, 0); a1[t] = __builtin_amdgcn_mfma_f32_16x16x32_bf16(sa[1][t], vb1, a1[t], 0, 0, 0); }
                SBAR();
            }
            u32x2 qf[2][8];
#define ML_QLOAD(s, b) do { const int qo = ((s) >> 2) ? ML_Q1 : ML_Q0; const unsigned qa1 = qrb ^ (64u * ((s) & 3)), qa2 = qrb ^ (64u * ((s) & 3) + 32u);   \
                _Pragma("unroll") for (int t = 0; t < 4; ++t) { qf[b][2 * t] = *(const LAS u32x2*)(lds + qo + 4096 * t + qa1); qf[b][2 * t + 1] = *(const LAS u32x2*)(lds + qo + 4096 * t + qa2); } } while (0)
            ML_QLOAD(0, 0);
#pragma unroll
            for (int s = 0; s < 8; ++s) {
                if (s < 7) ML_QLOAD(s + 1, (s + 1) & 1);
                u32x4 cbw; cbw.x = cvt_pk_bf16(C[2 * s][0], C[2 * s][1]); cbw.y = cvt_pk_bf16(C[2 * s][2], C[2 * s][3]);
                cbw.z = cvt_pk_bf16(C[2 * s + 1][0], C[2 * s + 1][1]); cbw.w = cvt_pk_bf16(C[2 * s + 1][2], C[2 * s + 1][3]);
                const bf16x8 cb = *reinterpret_cast<const bf16x8*>(&cbw);
#pragma unroll
                for (int t = 0; t < 4; ++t) {
                    u32x4 qw; qw.x = qf[s & 1][2 * t].x; qw.y = qf[s & 1][2 * t].y; qw.z = qf[s & 1][2 * t + 1].x; qw.w = qf[s & 1][2 * t + 1].y;
                    a2[t] = __builtin_amdgcn_mfma_f32_16x16x32_bf16(*reinterpret_cast<const bf16x8*>(&qw), cb, a2[t], 0, 0, 0);
                }
                SBAR();
            }
#undef ML_QLOAD
            bf16_t* hp = hout + (size_t)seqrow * 1024 + head * 256 + dvh * 128 + 16 * w + l15;
#pragma unroll
            for (int t = 0; t < 4; ++t) {
                const int i0 = 16 * t + 4 * g;
                const f32x4 wi4 = *(const LAS f32x4*)(tab + 128 + i0), em4 = *(const LAS f32x4*)(tab + 192 + i0), qn4 = *(const LAS f32x4*)(qn + i0);
                const f32x4 d0 = *(const LAS f32x4*)(dp + 2 * i0), d1 = *(const LAS f32x4*)(dp + 2 * i0 + 4);
                const float dsum[4] = {d0[0] + d0[1], d0[2] + d0[3], d1[0] + d1[1], d1[2] + d1[3]};
#pragma unroll
                for (int r = 0; r < 4; ++r) {
                    const float den = dsum[r] + wi4[r] * qn4[r];
                    const float num = a1[t][r] + wi4[r] * a2[t][r];
                    const float hv = num * __builtin_amdgcn_rcpf(fmaxf(fabsf(den), em4[r]));
                    const int i = i0 + r; const int tok = dir ? t0 + 63 - i : t0 + i;
                    hp[(size_t)tok * 1024] = f2bf(hv);
                }
            }
        }
        SBAR();
        if (c + 1 < NC) ML_LOAD(c + 1);
        {
            {
                const unsigned tn = (trb + ((w >> 2) ? 16384u : 0u)) ^ (64u * (unsigned)(w & 3));
                KF fn; kf_issue<0, 0>(fn, tn);
                const f32x4 k0a = *(const LAS f32x4*)(tab + 256 + 8 * g), k0b = *(const LAS f32x4*)(tab + 260 + 8 * g), k1a = *(const LAS f32x4*)(tab + 288 + 8 * g), k1b = *(const LAS f32x4*)(tab + 292 + 8 * g);
                u32x4 nw0, nw1, nx0, nx1;
                nw0.x = cvt_pk_bf16(k0a[0], k0a[1]); nw0.y = cvt_pk_bf16(k0a[2], k0a[3]); nw0.z = cvt_pk_bf16(k0b[0], k0b[1]); nw0.w = cvt_pk_bf16(k0b[2], k0b[3]);
                nw1.x = cvt_pk_bf16(k1a[0], k1a[1]); nw1.y = cvt_pk_bf16(k1a[2], k1a[3]); nw1.z = cvt_pk_bf16(k1b[0], k1b[1]); nw1.w = cvt_pk_bf16(k1b[2], k1b[3]);
                nx0.x = cvt_pk_bf16(k0a[0] - bflo(nw0.x), k0a[1] - bfhi(nw0.x)); nx0.y = cvt_pk_bf16(k0a[2] - bflo(nw0.y), k0a[3] - bfhi(nw0.y)); nx0.z = cvt_pk_bf16(k0b[0] - bflo(nw0.z), k0b[1] - bfhi(nw0.z)); nx0.w = cvt_pk_bf16(k0b[2] - bflo(nw0.w), k0b[3] - bfhi(nw0.w));
                nx1.x = cvt_pk_bf16(k1a[0] - bflo(nw1.x), k1a[1] - bfhi(nw1.x)); nx1.y = cvt_pk_bf16(k1a[2] - bflo(nw1.y), k1a[3] - bfhi(nw1.y)); nx1.z = cvt_pk_bf16(k1b[0] - bflo(nw1.z), k1b[1] - bfhi(nw1.z)); nx1.w = cvt_pk_bf16(k1b[2] - bflo(nw1.w), k1b[3] - bfhi(nw1.w));
                if (l15 != 0) { nw0 = (u32x4){0u, 0u, 0u, 0u}; nw1 = nw0; nx0 = nw0; nx1 = nw0; }
                const bf16x8 nb0 = *reinterpret_cast<const bf16x8*>(&nw0), nb1 = *reinterpret_cast<const bf16x8*>(&nw1), nl0 = *reinterpret_cast<const bf16x8*>(&nx0), nl1 = *reinterpret_cast<const bf16x8*>(&nx1);
                LAS f32x4* pa = (LAS f32x4*)(nst + 32 * w + 4 * g); LAS f32x4* pb = (LAS f32x4*)(nst + 32 * w + 16 + 4 * g);
                f32x4 na = *pa * decay_c, nb = *pb * decay_c;
                LDS_WAIT(); SBAR();
                const bf16x8 A0 = ML_PK(fn.a00, fn.a01), A1 = ML_PK(fn.a10, fn.a11), B0 = ML_PK(fn.b00, fn.b01), B1 = ML_PK(fn.b10, fn.b11);
                na = __builtin_amdgcn_mfma_f32_16x16x32_bf16(A0, nb0, na, 0, 0, 0); nb = __builtin_amdgcn_mfma_f32_16x16x32_bf16(B0, nb0, nb, 0, 0, 0);
                na = __builtin_amdgcn_mfma_f32_16x16x32_bf16(A1, nb1, na, 0, 0, 0); nb = __builtin_amdgcn_mfma_f32_16x16x32_bf16(B1, nb1, nb, 0, 0, 0);
                na = __builtin_amdgcn_mfma_f32_16x16x32_bf16(A0, nl0, na, 0, 0, 0); nb = __builtin_amdgcn_mfma_f32_16x16x32_bf16(B0, nl0, nb, 0, 0, 0);
                na = __builtin_amdgcn_mfma_f32_16x16x32_bf16(A1, nl1, na, 0, 0, 0); nb = __builtin_amdgcn_mfma_f32_16x16x32_bf16(B1, nl1, nb, 0, 0, 0);
                if (l15 == 0) { *pa = na; *pb = nb; }
                SBAR();
            }
            const s16x4 w00 = trr<ML_VW>(tbw ^ trc(0, 0, 0)), w01 = trr<ML_VW>(tbw ^ trc(0, 0, 1)), w10 = trr<ML_VW>(tbw ^ trc(0, 1, 0)), w11 = trr<ML_VW>(tbw ^ trc(0, 1, 1));
            KF f0, f1;
            kf_issue<ML_K0, 0>(f0, trb);
#pragma unroll
            for (int t = 0; t < 16; ++t) C[t] = C[t] * decay_c;
            LDS_WAIT(); SBAR();
            const bf16x8 wb0 = ML_PK(w00, w01), wb1 = ML_PK(w10, w11);
            kf_issue<ML_K0, 2>(f1, trb); ML_WAITL(8); SBAR(); kf_mma(C[0], C[1], f0, wb0, wb1); SBAR();
            kf_issue<ML_K0, 4>(f0, trb); ML_WAITL(8); SBAR(); kf_mma(C[2], C[3], f1, wb0, wb1); SBAR();
            kf_issue<ML_K0, 6>(f1, trb); ML_WAITL(8); SBAR(); kf_mma(C[4], C[5], f0, wb0, wb1); SBAR();
            kf_issue<ML_K1, 0>(f0, trb); ML_WAITL(8); SBAR(); kf_mma(C[6], C[7], f1, wb0, wb1); SBAR();
            kf_issue<ML_K1, 2>(f1, trb); ML_WAITL(8); SBAR(); kf_mma(C[8], C[9], f0, wb0, wb1); SBAR();
            kf_issue<ML_K1, 4>(f0, trb); ML_WAITL(8); SBAR(); kf_mma(C[10], C[11], f1, wb0, wb1); SBAR();
            kf_issue<ML_K1, 6>(f1, trb); ML_WAITL(8); SBAR(); kf_mma(C[12], C[13], f0, wb0, wb1); SBAR();
            ML_WAITL(0); SBAR(); kf_mma(C[14], C[15], f1, wb0, wb1); SBAR();
        }
        __syncthreads();
        if (c + 1 < NC) { ML_SCALARS(); ML_STAGE(); }
        __syncthreads();
    }
#undef ML_LOAD
#undef ML_SCALARS
#undef ML_STAGE
}
}

struct Args {
    const float* x_prompt; const float* x_sample; const float* p_prompt; const float* p_sample;
    const float* norm_pre; const float* w_in; const float* b_gate; const float* w_pool; const float* pool_scale;
    const float* mlstm_norm; const float* q_norm; const float* k_norm; const float* w_out; const float* norm_post;
    const float* w_ple_proj; const float* w_ple_gate; const float* ple_norm;
    float* out; unsigned char* ws; int ph_lo, ph_hi;
};

typedef const Args __attribute__((address_space(4)))* KArgsP;
__device__ __forceinline__ Args load_args(KArgsP p) {
    Args a; a.x_prompt = p->x_prompt; a.x_sample = p->x_sample; a.p_prompt = p->p_prompt; a.p_sample = p->p_sample; a.norm_pre = p->norm_pre; a.w_in = p->w_in; a.b_gate = p->b_gate; a.w_pool = p->w_pool;
    a.pool_scale = p->pool_scale; a.mlstm_norm = p->mlstm_norm; a.q_norm = p->q_norm; a.k_norm = p->k_norm; a.w_out = p->w_out; a.norm_post = p->norm_post; a.w_ple_proj = p->w_ple_proj; a.w_ple_gate = p->w_ple_gate;
    a.ple_norm = p->ple_norm; a.out = p->out; a.ws = p->ws; a.ph_lo = p->ph_lo; a.ph_hi = p->ph_hi; return a;
}
__device__ const double ROPE_INV[32] = {
    1.0, 0.7498942093324559, 0.5623413251903491, 0.4216965034285822, 0.31622776601683794, 0.23713737056616552, 0.1778279410038923, 0.1333521432163324,
    0.1, 0.07498942093324558, 0.05623413251903491, 0.04216965034285822, 0.03162277660168379, 0.023713737056616554, 0.01778279410038923, 0.01333521432163324,
    0.01, 0.007498942093324558, 0.005623413251903491, 0.004216965034285823, 0.0031622776601683794, 0.0023713737056616554, 0.0017782794100389228, 0.001333521432163324,
    0.001, 0.0007498942093324559, 0.0005623413251903491, 0.0004216965034285823, 0.00031622776601683794, 0.00023713737056616554, 0.00017782794100389227, 0.0001333521432163324};

__device__ __forceinline__ void transpose_item(const float* __restrict__ W, int ldw, int srcc0, int K, bf16_t* __restrict__ WT, int n0, int k0, LAS float* scr, int lane) {
    { const int kr = lane >> 3, c4 = lane & 7;
      f32x4 x[8];
#pragma unroll
      for (int i = 0; i < 8; ++i) x[i] = *(const f32x4*)(W + (size_t)(k0 + 8 * i + kr) * ldw + srcc0 + 4 * c4);
#pragma unroll
      for (int i = 0; i < 8; ++i) { LAS float* d = scr + (8 * i + kr) * 33 + 4 * c4; d[0] = x[i][0]; d[1] = x[i][1]; d[2] = x[i][2]; d[3] = x[i][3]; } }
    LDS_WAIT(); asm volatile("" ::: "memory");
    const int c = lane & 7;
#pragma unroll
    for (int j = 0; j < 4; ++j) { const int n = (lane >> 3) + 8 * j; const LAS float* s = scr + (8 * c) * 33 + n;
        u32x4 o; o.x = cvt_pk_bf16(s[0 * 33], s[1 * 33]); o.y = cvt_pk_bf16(s[2 * 33], s[3 * 33]); o.z = cvt_pk_bf16(s[4 * 33], s[5 * 33]); o.w = cvt_pk_bf16(s[6 * 33], s[7 * 33]);
        *(u32x4*)(WT + (size_t)(n0 + n) * K + k0 + 8 * c) = o; }
    LDS_WAIT(); asm volatile("" ::: "memory");
}

__device__ __forceinline__ void convert_layer_weights(const Args& a, int l, int gw, int ngw, LAS float* scr, int lane) {
    unsigned char* ws = a.ws;
    bf16_t* WIN = (bf16_t*)(ws + WS_WIN); bf16_t* WOUT = (bf16_t*)(ws + WS_WOUT); bf16_t* WGATE = (bf16_t*)(ws + WS_WGATE); bf16_t* WPROJ = (bf16_t*)(ws + WS_WPROJ); bf16_t* WPOOL = (bf16_t*)(ws + WS_WPOOL);
    constexpr int I_IN = 64 * 384, I_SQ = 64 * 128, I_PJ = 4 * 128, I_PL = 4 * 8;
    constexpr int NIT = I_IN + 2 * I_SQ + I_PJ + 4 * I_PL;
    for (int it = gw; it < NIT; it += ngw) {
        int r = it;
        if (r < I_IN) { const int kb = r / 384, nb = r % 384, n0 = nb * 32; transpose_item(a.w_in + (size_t)l * DM * NINSRC, NINSRC, n0 + (n0 >= 7168 ? 16 : 0), DM, WIN, n0, kb * 64, scr, lane); continue; } r -= I_IN;
        if (r < I_SQ) { const int kb = r / 128, nb = r % 128; transpose_item(a.w_out + (size_t)l * DM * DM, DM, nb * 32, DM, WOUT, nb * 32, kb * 64, scr, lane); continue; } r -= I_SQ;
        if (r < I_SQ) { const int kb = r / 128, nb = r % 128; transpose_item(a.w_ple_gate + (size_t)l * DM * DM, DM, nb * 32, DM, WGATE, nb * 32, kb * 64, scr, lane); continue; } r -= I_SQ;
        if (r < I_PJ) { const int kb = r / 128, nb = r % 128; transpose_item(a.w_ple_proj + (size_t)l * PLE * DM, DM, nb * 32, PLE, WPROJ, nb * 32, kb * 64, scr, lane); continue; } r -= I_PJ;
        { const int gq = r / I_PL, rr = r % I_PL, kb = rr / 8, nb = rr % 8; transpose_item(a.w_pool + (size_t)(l * 4 + gq) * 65536, 256, nb * 32, 256, WPOOL + (size_t)gq * 65536, nb * 32, kb * 64, scr, lane); }
    }
}

__device__ __forceinline__ const float* xrow_ptr(const Args& a, int row) { return row < NPROMPT ? a.x_prompt + (size_t)row * DM : a.x_sample + (size_t)(row - NPROMPT) * DM; }

template <int SRC>
__device__ __forceinline__ void norm_gates_phase(const Args& a, int lnext, int lprev, int gw, int ngw, int lane) {
    unsigned char* ws = a.ws;
    bf16_t* H = (bf16_t*)(ws + WS_H); const bf16_t* PL = (const bf16_t*)(ws + WS_Y); const float* stats = (const float*)(ws + WS_STATS);
    float* gates = (float*)(ws + WS_GATES);
    for (int grp = gw; grp < NTOK / 16; grp += ngw) {
        for (int rr = 0; rr < 16; ++rr) {
            const int row = grp * 16 + rr;
            f32x4 v[8][2];
            if (SRC == 0) {
                const f32x4* xr = (const f32x4*)xrow_ptr(a, row) + 2 * lane;
#pragma unroll
                for (int j = 0; j < 8; ++j) { v[j][0] = __builtin_nontemporal_load(xr + 128 * j); v[j][1] = __builtin_nontemporal_load(xr + 128 * j + 1); }
            } else {
                const float st = stats[(size_t)row * 64 + lane];
                const float rstd = __builtin_amdgcn_rsqf(wave_sum(st) * (1.f / DM) + EPS);
                f32x4* xr = (f32x4*)(a.out + (size_t)row * DM) + 2 * lane;
                u32x4* xbr = (u32x4*)((bf16_t*)a.out + (size_t)row * DM) + lane;
                const u32x4* x1r = (const u32x4*)(H + (size_t)row * DM) + lane;
                const u32x4* pr = (const u32x4*)(PL + (size_t)row * DM) + lane;
                const f32x4* gr = (const f32x4*)(a.ple_norm + (size_t)lprev * DM) + 2 * lane;
                u32x4 xq[8], pq[8];
#pragma unroll
                for (int j = 0; j < 8; ++j) { xq[j] = __builtin_nontemporal_load(x1r + 64 * j); pq[j] = __builtin_nontemporal_load(pr + 64 * j); }
#pragma unroll
                for (int j = 0; j < 8; ++j) { const u32x4 x = xq[j], p = pq[j]; const f32x4 g0 = gr[128 * j], g1 = gr[128 * j + 1];
                    f32x4 y0, y1;
                    y0[0] = bflo(x.x) + bflo(p.x) * rstd * g0[0]; y0[1] = bfhi(x.x) + bfhi(p.x) * rstd * g0[1]; y0[2] = bflo(x.y) + bflo(p.y) * rstd * g0[2]; y0[3] = bfhi(x.y) + bfhi(p.y) * rstd * g0[3];
                    y1[0] = bflo(x.z) + bflo(p.z) * rstd * g1[0]; y1[1] = bfhi(x.z) + bfhi(p.z) * rstd * g1[1]; y1[2] = bflo(x.w) + bflo(p.w) * rstd * g1[2]; y1[3] = bfhi(x.w) + bfhi(p.w) * rstd * g1[3];
                    v[j][0] = y0; v[j][1] = y1;
                    if (lnext < DEPTH) { u32x4 o; o.x = cvt_pk_bf16(y0[0], y0[1]); o.y = cvt_pk_bf16(y0[2], y0[3]); o.z = cvt_pk_bf16(y1[0], y1[1]); o.w = cvt_pk_bf16(y1[2], y1[3]); xbr[64 * j] = o; }
                    else { xr[128 * j] = y0; xr[128 * j + 1] = y1; } }
            }
            if (lnext < DEPTH) {
                float ss = 0.f;
#pragma unroll
                for (int j = 0; j < 8; ++j)
#pragma unroll
                    for (int h2 = 0; h2 < 2; ++h2) ss += (v[j][h2][0] * v[j][h2][0] + v[j][h2][1] * v[j][h2][1]) + (v[j][h2][2] * v[j][h2][2] + v[j][h2][3] * v[j][h2][3]);
                const float r = __builtin_amdgcn_rsqf(wave_sum(ss) * (1.f / DM) + EPS);
                const f32x4* gr = (const f32x4*)(a.norm_pre + (size_t)lnext * DM) + 2 * lane;
                u32x4* o8 = (u32x4*)(H + (size_t)row * DM) + lane;
#pragma unroll
                for (int j = 0; j < 8; ++j) { const f32x4 g0 = gr[128 * j], g1 = gr[128 * j + 1]; u32x4 o;
                    o.x = cvt_pk_bf16(v[j][0][0] * r * g0[0], v[j][0][1] * r * g0[1]); o.y = cvt_pk_bf16(v[j][0][2] * r * g0[2], v[j][0][3] * r * g0[3]);
                    o.z = cvt_pk_bf16(v[j][1][0] * r * g1[0], v[j][1][1] * r * g1[1]); o.w = cvt_pk_bf16(v[j][1][2] * r * g1[2], v[j][1][3] * r * g1[3]); o8[64 * j] = o; }
            }
        }
        if (lnext < DEPTH) {
            VM_WAIT();
            const bf16_t* Hg = H + (size_t)(grp * 16 + (lane & 15)) * DM + 8 * (lane >> 4);
            const bf16_t* Wg = (const bf16_t*)(ws + WS_WG) + (size_t)lnext * 16 * DM + (size_t)(lane & 15) * DM + 8 * (lane >> 4);
            f32x4 acc = (f32x4){0.f, 0.f, 0.f, 0.f};
#pragma unroll 8
            for (int ks = 0; ks < DM / 32; ++ks) {
                const bf16x8 af = *(const bf16x8*)(Hg + ks * 32), bf = *(const bf16x8*)(Wg + ks * 32);
                acc = __builtin_amdgcn_mfma_f32_16x16x32_bf16(af, bf, acc, 0, 0, 0);
            }
            const int col = lane & 15; const float bias = a.b_gate[lnext * 16 + col]; const bool isf = (col & 4) != 0;
#pragma unroll
            for (int r = 0; r < 4; ++r) { float gv = acc[r] + bias;
                if (isf) { const float e = fast_exp(-fabsf(gv)); gv = fminf(gv, 0.f) - __logf(1.f + e); }
                gates[(size_t)(grp * 16 + 4 * (lane >> 4) + r) * 16 + col] = gv; }
        }
    }
}

constexpr int NCOMB = 128;
constexpr int PH_PRO = 0, PH_NORM0 = 1, PH_L0 = 2, PH_PER_LAYER = 8, N_PHASES = PH_L0 + DEPTH * PH_PER_LAYER;

#define PHASE_IDS() const int tid = opaque_tid(), lane = tid & 63, wave = __builtin_amdgcn_readfirstlane(tid >> 6), gw = bx * NWAVES + wave, gt = bx * (NWAVES * 64) + tid; (void)lane; (void)gw; (void)gt
#if MK_ONE_LAUNCH
#define GRID_BAR() xcd_barrier(bar)
#else
#define GRID_BAR() do {} while (0)
#endif
#ifdef ONLY_SUB
#define IN(k) (((k) < PH_L0 ? 100 + (k) : ((k) - PH_L0) % PH_PER_LAYER) == ONLY_SUB && lo <= (k) && (k) < hi)
#else
#define IN(k) (lo <= (k) && (k) < hi)
#endif
#define SEAM(k) do { if (IN(k) && IN((k) + 1)) GRID_BAR(); } while (0)
#define PHASE_PTRS() KArgsP ap_ = (KArgsP)__builtin_amdgcn_kernarg_segment_ptr(); asm volatile("" : "+s"(ap_)); \
    const Args a = load_args(ap_); unsigned char* ws = a.ws; (void)ws; \
    bf16_t* WIN = (bf16_t*)(ws + WS_WIN); bf16_t* WOUT = (bf16_t*)(ws + WS_WOUT); bf16_t* WGATE = (bf16_t*)(ws + WS_WGATE); bf16_t* WPROJ = (bf16_t*)(ws + WS_WPROJ); bf16_t* WPOOL = (bf16_t*)(ws + WS_WPOOL); bf16_t* WG = (bf16_t*)(ws + WS_WG); \
    bf16_t* PB = (bf16_t*)(ws + WS_PB); bf16_t* H = (bf16_t*)(ws + WS_H); bf16_t* ZIN = (bf16_t*)(ws + WS_ZIN); bf16_t* DPOOL = (bf16_t*)(ws + WS_DPOOL); \
    bf16_t* HF = (bf16_t*)(ws + WS_HF); bf16_t* HB = (bf16_t*)(ws + WS_HB); bf16_t* Y = (bf16_t*)(ws + WS_Y); bf16_t* YO = (bf16_t*)(ws + WS_YO); bf16_t* PP = (bf16_t*)(ws + WS_PP); \
    float* STATS = (float*)(ws + WS_STATS); float* GATES = (float*)(ws + WS_GATES); f32x2* ROPE = (f32x2*)(ws + WS_ROPE); float* GSC = (float*)(ws + WS_GSC); float* CHS = (float*)(ws + WS_CHS); unsigned* ctl = (unsigned*)(ws + WS_CTL); bf16_t* KC = (bf16_t*)(ws + WS_KC); bf16_t* VC = (bf16_t*)(ws + WS_VC); (void)KC; (void)VC; \
    (void)WIN; (void)WOUT; (void)WGATE; (void)WPROJ; (void)WPOOL; (void)WG; (void)PB; (void)H; (void)ZIN; (void)DPOOL; (void)HF; (void)HB; (void)Y; (void)YO; (void)PP; (void)STATS; (void)GATES; (void)ROPE; (void)GSC; (void)CHS; (void)ctl

template <int l>
__device__ __forceinline__ void layer_body(LAS unsigned char* lds, unsigned char* lds_raw, volatile LAS unsigned* MISC, const XcdBarrier& bar, int G, int bx, int vcu, int ngw, int ngt, int lo, int hi) {
        const int pb = PH_L0 + l * PH_PER_LAYER;
        if (IN(pb + 0)) for (int rep_ = 0; rep_ < PROBE_INPROJ; ++rep_) {
            PHASE_PTRS();
            pg8::Gemm g{H, WIN, NTOK, NIN, DM, DM, DM, 0}; pg8::StaticOrder S; S.init(NTOK, NIN, G, bx);
            Epi<0> E{ZIN, NIN, nullptr, nullptr, 0, nullptr};
            pg8::gemm_phase<Epi<0>>(lds, g, S, E);
        }
        SEAM(pb + 0);
        if (IN(pb + 1)) {
            PHASE_PTRS(); PHASE_IDS();
            {
                const int hq = lane >> 4, e0 = 8 * (lane & 15);
                const int halfid = e0 >> 6, eh = e0 & 63; const bool isb = eh >= 32; const int f0 = eh & 31;
                float gq[8], gk[8];
                { const float* gn = a.q_norm + l * 128 + e0; const f32x4 g0 = *(const f32x4*)gn, g1 = *(const f32x4*)(gn + 4); gq[0] = g0[0]; gq[1] = g0[1]; gq[2] = g0[2]; gq[3] = g0[3]; gq[4] = g1[0]; gq[5] = g1[1]; gq[6] = g1[2]; gq[7] = g1[3];
#pragma unroll
                  for (int j = 0; j < 8; ++j) gq[j] *= att::SCALE * 1.4426950408889634f; }
                { const float* gn = a.k_norm + l * 128 + e0; const f32x4 g0 = *(const f32x4*)gn, g1 = *(const f32x4*)(gn + 4); gk[0] = g0[0]; gk[1] = g0[1]; gk[2] = g0[2]; gk[3] = g0[3]; gk[4] = g1[0]; gk[5] = g1[1]; gk[6] = g1[2]; gk[7] = g1[3]; }
                for (int row = gw; row < NTOK; row += ngw) {
                    const int pos = row < NPROMPT ? (row & 8191) : (row & 4095);
                    bf16_t* zr = ZIN + (size_t)row * NIN;
                    u32x4 xin[5];
#pragma unroll
                    for (int q = 0; q < 5; ++q) xin[q] = *(const u32x4*)(zr + (q < 4 ? C_AQ + (q * 4 + hq) * 128 : C_AK + hq * 128) + e0);
                    const int rp = halfid ? (pos & 63) : (pos >> 6);
                    const f32x4* cs4 = (const f32x4*)(ROPE + rp * 32 + f0);
                    const f32x4 c01 = cs4[0], c23 = cs4[1], c45 = cs4[2], c67 = cs4[3];
                    const float cc[8] = {c01[0], c01[2], c23[0], c23[2], c45[0], c45[2], c67[0], c67[2]}, sn[8] = {c01[1], c01[3], c23[1], c23[3], c45[1], c45[3], c67[1], c67[3]};
#pragma unroll
                    for (int q = 0; q < 5; ++q) {
                        const u32x4 x = xin[q];
                        float v[8] = {bflo(x.x), bfhi(x.x), bflo(x.y), bfhi(x.y), bflo(x.z), bfhi(x.z), bflo(x.w), bfhi(x.w)};
                        float ss = 0.f;
#pragma unroll
                        for (int j = 0; j < 8; ++j) ss += v[j] * v[j];
                        ss = addx<1>(ss); ss = addx<2>(ss); ss = addx<4>(ss); ss = addx<8>(ss);
                        const float r = __builtin_amdgcn_rsqf(ss * (1.f / 128.f) + EPS);
                        float o[8];
#pragma unroll
                        for (int j = 0; j < 8; ++j) { const float xn = v[j] * r * (q < 4 ? gq[j] : gk[j]); const float pj = swz_xor<4>(xn); o[j] = isb ? xn * cc[j] + pj * sn[j] : xn * cc[j] - pj * sn[j]; }
                        u32x4 w; w.x = cvt_pk_bf16(o[0], o[1]); w.y = cvt_pk_bf16(o[2], o[3]); w.z = cvt_pk_bf16(o[4], o[5]); w.w = cvt_pk_bf16(o[6], o[7]);
                        if (q < 4) *(u32x4*)(zr + C_AQ + (q * 4 + hq) * 128 + e0) = w; else *(u32x4*)(KC + ((size_t)hq * NTOK + row) * 128 + e0) = w;
                    }
                }
            }
            {
                const int c8 = lane & 31, rsel = lane >> 5;
                for (int rp = gw; rp < NTOK / 2; rp += ngw) {
                    const int row = rp * 2 + rsel;
                    const int slen = row < NPROMPT ? 8192 : 4096, pos = row & (slen - 1);
                    const bf16_t* ub = ZIN + (size_t)(row - pos) * NIN + C_PU + c8 * 8;
                    u32x4 xa[2], xb[4], xc[8], xd[16]; int ca = 0, cb = 0, cc = 0, cd = 0;
#define POOL_LD(X, W, G, CNT) do { _Pragma("unroll") for (int k = 0; k < (W); ++k) { const int t = pos - (W) / 2 + k; const bool ok = t >= 0 && t < slen; \
                        X[k] = ok ? *(const u32x4*)(ub + (size_t)(ok ? t : pos) * NIN + (G) * 256) : (u32x4){0u, 0u, 0u, 0u}; CNT += ok ? 1 : 0; } } while (0)
                    POOL_LD(xa, 2, 0, ca); POOL_LD(xb, 4, 1, cb); POOL_LD(xc, 8, 2, cc); POOL_LD(xd, 16, 3, cd);
#undef POOL_LD
#define POOL_OUT(X, W, G, CNT) do { float s_[8] = {0.f, 0.f, 0.f, 0.f, 0.f, 0.f, 0.f, 0.f}; \
                        _Pragma("unroll") for (int k = 0; k < (W); ++k) { s_[0] += bflo(X[k].x); s_[1] += bfhi(X[k].x); s_[2] += bflo(X[k].y); s_[3] += bfhi(X[k].y); s_[4] += bflo(X[k].z); s_[5] += bfhi(X[k].z); s_[6] += bflo(X[k].w); s_[7] += bfhi(X[k].w); } \
                        const u32x4 c_ = X[(W) / 2]; const float inv = 1.f / (float)(CNT); u32x4 w; \
                        w.x = cvt_pk_bf16(s_[0] * inv - bflo(c_.x), s_[1] * inv - bfhi(c_.x)); w.y = cvt_pk_bf16(s_[2] * inv - bflo(c_.y), s_[3] * inv - bfhi(c_.y)); \
                        w.z = cvt_pk_bf16(s_[4] * inv - bflo(c_.z), s_[5] * inv - bfhi(c_.z)); w.w = cvt_pk_bf16(s_[6] * inv - bflo(c_.w), s_[7] * inv - bfhi(c_.w)); \
                        *(u32x4*)(DPOOL + (size_t)row * 1024 + (G) * 256 + c8 * 8) = w; } while (0)
                    POOL_OUT(xa, 2, 0, ca); POOL_OUT(xb, 4, 1, cb); POOL_OUT(xc, 8, 2, cc); POOL_OUT(xd, 16, 3, cd);
#undef POOL_OUT
                }
            }
            if (gw == 0) {
                float gq_ = fmaxf(fabsf(a.q_norm[l * 128 + lane]), fabsf(a.q_norm[l * 128 + 64 + lane])), gk_ = fmaxf(fabsf(a.k_norm[l * 128 + lane]), fabsf(a.k_norm[l * 128 + 64 + lane]));
#pragma unroll
                for (int o_ = 1; o_ < 64; o_ <<= 1) { gq_ = fmaxf(gq_, shfl_from(gq_, lane ^ o_)); gk_ = fmaxf(gk_, shfl_from(gk_, lane ^ o_)); }
                if (lane == 0) *((float*)(ws + WS_ABOUND) + l) = 128.f * gq_ * gk_ * 1.02f;
            }
            for (int it = gw; it < 2 * 512 * 4; it += ngw) {
                const int head = it & 3, ck = (it >> 2) & 511, dir = it >> 11;
                const int tok = dir ? ck * 64 + 63 - lane : ck * 64 + lane;
                const float li = GATES[(size_t)tok * 16 + (dir ? 8 : 0) + head], lf = GATES[(size_t)tok * 16 + (dir ? 12 : 4) + head];
                const float b = ml::scan_add(lf, lane), av = li - b, cm = ml::scan_max(av, lane);
                *(f32x4*)(GSC + (((size_t)dir * NTOK + tok) * 4 + head) * 4) = (f32x4){av, cm, b, 0.f};
                if (lane == 63) *(f32x2*)(CHS + (((size_t)dir * 512 + ck) * 4 + head) * 2) = (f32x2){b, cm};
            }
        }
        SEAM(pb + 1);
        if (IN(pb + 2)) {
            PHASE_PTRS();
#if !defined(ONLY_PART) || ONLY_PART == 0
            for (int rep_ = 0; rep_ < PROBE_SMALLGEMM; ++rep_)
            { pg8::Gemm g{DPOOL, WPOOL, NTOK, 1024, 256, 1024, 256, 256}; pg8::StaticOrder S; S.init(NTOK, 1024, G, bx);
              Epi<1> E{Y, DM, a.pool_scale + l * 1024, ZIN + C_PZ, NIN, nullptr};
              pg8::gemm_phase<Epi<1>>(lds, g, S, E); }
#endif
            const float Rb = __int_as_float(__builtin_amdgcn_readfirstlane(__float_as_int(((const float*)(ws + WS_ABOUND))[l + (threadIdx.x >> 10)])));
            const bool noshift = Rb * (att::SCALE * 1.4426950408889634f) <= 57.f;
            for (int rep_ = 0; rep_ < PROBE_MIX; ++rep_) {
            if (threadIdx.x == 0) MISC[17] = 0u;
            for (int qi = 0; qi < 8; ++qi) {
                const int xq = (bx + qi) & 7;
                unsigned* qh = ctl + 8192 + 64 * ((l + 2 * rep_) * 8 + xq);
                for (;;) {
                    if (threadIdx.x == 0) MISC[16] = __hip_atomic_fetch_add(qh, 1u, __ATOMIC_RELAXED, __HIP_MEMORY_SCOPE_AGENT);
                    __syncthreads();
                    const int idx = __builtin_amdgcn_readfirstlane((int)MISC[16]);
                    __syncthreads();
                    if (idx >= 12 + 256 + NCOMB) break;
                    if (idx >= 12 + 256) {
                        if (__builtin_amdgcn_readfirstlane(threadIdx.x >> 6) == 0 && __builtin_amdgcn_readfirstlane((int)MISC[17]) == 0) {
                            KArgsP ap2_ = (KArgsP)__builtin_amdgcn_kernarg_segment_ptr(); asm volatile("" : "+s"(ap2_));
                            unsigned* md_ = (unsigned*)(ap2_->ws + WS_CTL) + 12288 + 64 * l;
                            unsigned sp_ = 0; while ((unsigned)__builtin_amdgcn_readfirstlane((int)xb_ld(md_)) < 96u * 64u * PROBE_MLSTM) { __builtin_amdgcn_s_sleep(1); if (++sp_ > XB_SPIN_CAP) break; }
                            __builtin_amdgcn_fence(__ATOMIC_ACQUIRE, "agent");
                            MISC[17] = 1u;
                        }
                        __syncthreads();
                        const int tid = opaque_tid(), lane = tid & 63, wave = __builtin_amdgcn_readfirstlane(tid >> 6);
                        const int it0 = ((xq * NCOMB + (idx - 268)) * 8 + wave) * 8;
#pragma unroll 2
                        for (int k = 0; k < 8; ++k) {
                            const int it = it0 + k;
                            const int row = it >> 1, head = (it & 1) * 2 + (lane >> 5), e0 = 8 * (lane & 31);
                            const size_t ho = (size_t)row * 1024 + head * 256 + e0;
                            const u32x4 xf = *(const u32x4*)(HF + ho), xb = *(const u32x4*)(HB + ho);
                            float v[8] = {bflo(xf.x) + bflo(xb.x), bfhi(xf.x) + bfhi(xb.x), bflo(xf.y) + bflo(xb.y), bfhi(xf.y) + bfhi(xb.y), bflo(xf.z) + bflo(xb.z), bfhi(xf.z) + bfhi(xb.z), bflo(xf.w) + bflo(xb.w), bfhi(xf.w) + bfhi(xb.w)};
                            float ss = 0.f;
#pragma unroll
                            for (int j = 0; j < 8; ++j) ss += v[j] * v[j];
                            ss = addx<1>(ss); ss = addx<2>(ss); ss = addx<4>(ss); ss = addx<8>(ss); ss = addx<16>(ss);
                            const float r = __builtin_amdgcn_rsqf(ss * (1.f / 256.f) + EPS);
                            const float* gn = a.mlstm_norm + l * 1024 + head * 256 + e0;
                            const f32x4 g0 = *(const f32x4*)gn, g1 = *(const f32x4*)(gn + 4);
                            const u32x4 mo = *(const u32x4*)(ZIN + (size_t)row * NIN + C_MO + head * 256 + e0), mz = *(const u32x4*)(ZIN + (size_t)row * NIN + C_MZ + head * 256 + e0);
                            u32x4 w;
                            w.x = cvt_pk_bf16(v[0] * r * g0[0] * bflo(mo.x) * bflo(mz.x), v[1] * r * g0[1] * bfhi(mo.x) * bfhi(mz.x));
                            w.y = cvt_pk_bf16(v[2] * r * g0[2] * bflo(mo.y) * bflo(mz.y), v[3] * r * g0[3] * bfhi(mo.y) * bfhi(mz.y));
                            w.z = cvt_pk_bf16(v[4] * r * g1[0] * bflo(mo.z) * bflo(mz.z), v[5] * r * g1[1] * bfhi(mo.z) * bfhi(mz.z));
                            w.w = cvt_pk_bf16(v[6] * r * g1[2] * bflo(mo.w) * bflo(mz.w), v[7] * r * g1[3] * bfhi(mo.w) * bfhi(mz.w));
                            *(u32x4*)(Y + (size_t)row * DM + 1024 + head * 256 + e0) = w;
                        }
                    } else if (idx < 12) {
                        int seq, head, dir, dvh;
                        if (idx < 4) { seq = xq >> 2; head = xq & 3; dir = (idx >> 1) & 1; dvh = idx & 1; }
                        else { const int j = 8 * xq + (idx - 4); seq = 2 + (j >> 4); head = (j >> 2) & 3; dir = (j >> 1) & 1; dvh = j & 1; }
                        const int seqrow = seq < 2 ? seq * 8192 : NPROMPT + (seq - 2) * 4096, seqlen = seq < 2 ? 8192 : 4096;
                        for (int rep_ = 0; rep_ < PROBE_MLSTM; ++rep_) {
                            ml::mlstm_item(lds, ZIN, GSC, CHS, dir ? HB : HF, seqrow, seqlen, head, dir, dvh);
                            VM_WAIT(); __syncthreads();
                            if (__builtin_amdgcn_readfirstlane(threadIdx.x >> 6) == 0) {
                                KArgsP ap2_ = (KArgsP)__builtin_amdgcn_kernarg_segment_ptr(); asm volatile("" : "+s"(ap2_));
                                unsigned* md_ = (unsigned*)(ap2_->ws + WS_CTL) + 12288 + 64 * l;
                                __builtin_amdgcn_fence(__ATOMIC_RELEASE, "agent"); (void)xb_add(md_, 1u); }
                        }
                    } else {
                        const int u = idx - 12;
                        int seqrow, seqlen, head, qb;
                        if (u < 128) { const int b = xq >> 2, kvh = xq & 3; head = kvh * 4 + (u >> 5); qb = u & 31; seqrow = b * 8192; seqlen = 8192; }
                        else { const int u2 = u - 128, grp = 2 * xq + (u2 >> 6), u3 = u2 & 63; const int b = grp >> 2, kvh = grp & 3; head = kvh * 4 + (u3 >> 4); qb = u3 & 15; seqrow = NPROMPT + b * 4096; seqlen = 4096; }
                        const int kvh = head >> 2;
                        const bf16_t* Qb = ZIN + (size_t)(seqrow + qb * 256) * NIN + C_AQ + head * 128;
                        const bf16_t* Kh = KC + ((size_t)kvh * NTOK + seqrow) * 128;
                        const bf16_t* Vh = ZIN + (size_t)seqrow * NIN + C_AV + kvh * 128;
                        const bf16_t* Zb = ZIN + (size_t)(seqrow + qb * 256) * NIN + C_AZ + head * 128;
                        bf16_t* Yb = Y + (size_t)(seqrow + qb * 256) * DM + 2048 + head * 128;
                        for (int rep_ = 0; rep_ < PROBE_ATTN; ++rep_) { if (noshift) att::attn_unit<true>(Qb, Kh, Vh, Zb, Yb, seqlen, (char*)lds_raw, lds); else att::attn_unit<false>(Qb, Kh, Vh, Zb, Yb, seqlen, (char*)lds_raw, lds); }
                    }
                }
            }
            }
        }
        SEAM(pb + 2);
        if (IN(pb + 4)) for (int rep_ = 0; rep_ < PROBE_OUTPROJ; ++rep_) {
            PHASE_PTRS();
            pg8::Gemm g{Y, WOUT, NTOK, DM, DM, DM, DM, 0}; pg8::StaticOrder S; S.init(NTOK, DM, G, bx);
            Epi<3> E{YO, DM, nullptr, nullptr, 0, STATS};
            pg8::gemm_phase<Epi<3>>(lds, g, S, E);
        }
        SEAM(pb + 4);
        if (IN(pb + 5)) {
            PHASE_PTRS();
            const bool gemm_first = ((bx >> 3) & 1) == 0;
            for (int pass_ = 0; pass_ < 2; ++pass_) {
            if ((pass_ == 0) == gemm_first) {
            for (int rep_ = 0; rep_ < PROBE_SMALLGEMM; ++rep_)
            { pg8::Gemm g{PB + (size_t)l * NTOK * PLE, WPROJ, NTOK, DM, PLE, PLE, PLE, 0}; pg8::StaticOrder S; S.init(NTOK, DM, G, bx);
              Epi<2> E{PP, DM, nullptr, nullptr, 0, nullptr};
              pg8::gemm_phase<Epi<2>>(lds, g, S, E); }
            } else {
            PHASE_IDS();
            for (int rep_ = 0; rep_ < PROBE_X1; ++rep_)
            for (int row = gw; row < NTOK; row += ngw) {
                const float st = STATS[(size_t)row * 64 + lane];
                const float rstd = __builtin_amdgcn_rsqf(wave_sum(st) * (1.f / DM) + EPS);
                const f32x4* xr = (const f32x4*)xrow_ptr(a, row) + 2 * lane;
                const u32x4* xb = (const u32x4*)((const bf16_t*)a.out + (size_t)row * DM) + lane;
                const u32x4* yr = (const u32x4*)(YO + (size_t)row * DM) + lane;
                const f32x4* gr = (const f32x4*)(a.norm_post + (size_t)l * DM) + 2 * lane;
                u32x4* hr = (u32x4*)(H + (size_t)row * DM) + lane;
                f32x4 xv[8][2]; u32x4 pv[8];
#pragma unroll
                for (int j = 0; j < 8; ++j) {
                    if (l == 0) { xv[j][0] = __builtin_nontemporal_load(xr + 128 * j); xv[j][1] = __builtin_nontemporal_load(xr + 128 * j + 1); }
                    else { const u32x4 t = __builtin_nontemporal_load(xb + 64 * j); xv[j][0] = (f32x4){bflo(t.x), bfhi(t.x), bflo(t.y), bfhi(t.y)}; xv[j][1] = (f32x4){bflo(t.z), bfhi(t.z), bflo(t.w), bfhi(t.w)}; }
                    pv[j] = __builtin_nontemporal_load(yr + 64 * j); }
#pragma unroll
                for (int j = 0; j < 8; ++j) { const f32x4 x0 = xv[j][0], x1 = xv[j][1]; const u32x4 p = pv[j]; const f32x4 g0 = gr[128 * j], g1 = gr[128 * j + 1];
                    u32x4 o;
                    o.x = cvt_pk_bf16(x0[0] + bflo(p.x) * rstd * g0[0], x0[1] + bfhi(p.x) * rstd * g0[1]); o.y = cvt_pk_bf16(x0[2] + bflo(p.y) * rstd * g0[2], x0[3] + bfhi(p.y) * rstd * g0[3]);
                    o.z = cvt_pk_bf16(x1[0] + bflo(p.z) * rstd * g1[0], x1[1] + bfhi(p.z) * rstd * g1[1]); o.w = cvt_pk_bf16(x1[2] + bflo(p.w) * rstd * g1[2], x1[3] + bfhi(p.w) * rstd * g1[3]);
                    hr[64 * j] = o; }
            }
            }
            }
        }
        SEAM(pb + 5);
        for (int rep_ = 0; rep_ < PROBE_BAR; ++rep_) SEAM(pb + 5);
        if (IN(pb + 6)) for (int rep_ = 0; rep_ < PROBE_GATE; ++rep_) {
            PHASE_PTRS();
            pg8::Gemm g{H, WGATE, NTOK, DM, DM, DM, DM, 0}; pg8::StaticOrder S; S.init(NTOK, DM, G, bx);
            Epi<4> E{Y, DM, nullptr, PP, DM, STATS};
            pg8::gemm_phase<Epi<4>>(lds, g, S, E);
        }
        SEAM(pb + 6);
        if (IN(pb + 7)) { PHASE_PTRS(); PHASE_IDS(); if (l + 1 < DEPTH) convert_layer_weights(a, l + 1, gw, ngw, (LAS float*)(lds + wave * 16384), lane); norm_gates_phase<1>(a, l + 1, l, gw, ngw, lane); }
        if (l + 1 < DEPTH) SEAM(pb + 7);

}

__global__ void __launch_bounds__(NWAVES * 64, 2) fwd_kernel(Args a) {
    extern __shared__ __attribute__((aligned(16))) unsigned char lds_raw[];
    LAS unsigned char* lds = (LAS unsigned char*)lds_raw;
    volatile LAS unsigned* MISC = (volatile LAS unsigned*)(lds + MISC_OFF);
    const int G = gridDim.x, bx = blockIdx.x;
    const int vcu = (G % 8 == 0) ? (bx % 8) * (G / 8) + bx / 8 : bx;
    const int ngw = G * NWAVES, ngt = G * NWAVES * 64;
    if (threadIdx.x < 64) MISC[threadIdx.x] = 0u;
    __syncthreads();
#if MK_ONE_LAUNCH
    XcdBarrier bar = xcd_barrier_post((unsigned*)(a.ws + WS_CTL) + 4096, MISC + 8);
#else
    XcdBarrier bar; bar.bar = nullptr; bar.x = 0; bar.st = nullptr;
#endif
    const int lo = a.ph_lo, hi = a.ph_hi;
    if (IN(PH_PRO)) for (int rep_ = 0; rep_ < PROBE_PRO; ++rep_) {
        PHASE_PTRS(); PHASE_IDS();
        LAS float* scr = (LAS float*)(lds + wave * 16384);
        convert_layer_weights(a, 0, gw, ngw, scr, lane);
        for (int i = gt; i < DEPTH * 16 * DM; i += ngt) { const int l = i / (16 * DM), r = i % (16 * DM), gcol = r / DM, k = r % DM; WG[i] = f2bf(a.w_in[(size_t)l * DM * NINSRC + (size_t)k * NINSRC + 7168 + gcol]); }
        for (int i = gt; i < DEPTH * NTOK * PLE / 8; i += ngt) {
            const size_t e = (size_t)i * 8; const int l = (int)(e / ((size_t)NTOK * PLE)); const size_t r = e % ((size_t)NTOK * PLE);
            const float* src = r < (size_t)NPROMPT * PLE ? a.p_prompt + (size_t)l * NPROMPT * PLE + r : a.p_sample + (size_t)l * NPROMPT * PLE + (r - (size_t)NPROMPT * PLE);
            const f32x4 x0 = *(const f32x4*)src, x1 = *(const f32x4*)(src + 4);
            u32x4 o; o.x = cvt_pk_bf16(x0[0], x0[1]); o.y = cvt_pk_bf16(x0[2], x0[3]); o.z = cvt_pk_bf16(x1[0], x1[1]); o.w = cvt_pk_bf16(x1[2], x1[3]);
            *(u32x4*)(PB + e) = o;
        }
        for (int i = gt; i < 128 * 32; i += ngt) {
            const int pos = i >> 5, f = i & 31;
            const double ang = (double)pos * ROPE_INV[f];
            const double kk = __builtin_rint(ang * 0.15915494309189535), r = ang - kk * 6.283185307179586, r2 = r * r;
            double cs = 1.0, sn = r, tc = 1.0, tsn = r;
            for (int n = 1; n <= 16; ++n) { tc *= -r2 / (double)((2 * n - 1) * (2 * n)); cs += tc; tsn *= -r2 / (double)((2 * n) * (2 * n + 1)); sn += tsn; }
            ROPE[i] = (f32x2){(float)cs, (float)sn};
        }
    }
    SEAM(PH_PRO);
    if (IN(PH_NORM0)) for (int rep_ = 0; rep_ < PROBE_PRO; ++rep_) { PHASE_PTRS(); PHASE_IDS(); norm_gates_phase<0>(a, 0, 0, gw, ngw, lane); }
    SEAM(PH_NORM0);

    layer_body<0>(lds, lds_raw, MISC, bar, G, bx, vcu, ngw, ngt, lo, hi);
    layer_body<1>(lds, lds_raw, MISC, bar, G, bx, vcu, ngw, ngt, lo, hi);
    static_assert(DEPTH == 2, "two layer_body instantiations");
}


extern "C" void kernel_launch(void* const* d_in, const int* in_sizes, int n_in, void* d_out, int out_size, void* d_ws, size_t ws_size, hipStream_t stream) {
    static int grid = 0;
    if (grid == 0) {
        if (n_in != 17 || out_size != NTOK * DM || ws_size < WS_END) { fprintf(stderr, "kernel_launch: unexpected shapes: n_in %d out %d ws %zu (need %zu)\n", n_in, out_size, ws_size, (size_t)WS_END); grid = -1; return; }
        int dev = 0, cus = 0, per_cu = 0;
        if (hipGetDevice(&dev) != hipSuccess || hipDeviceGetAttribute(&cus, hipDeviceAttributeMultiprocessorCount, dev) != hipSuccess) { grid = -1; return; }
        if (hipFuncSetAttribute((const void*)fwd_kernel, hipFuncAttributeMaxDynamicSharedMemorySize, LDS_BYTES) != hipSuccess) { fprintf(stderr, "kernel_launch: hipFuncSetAttribute failed\n"); grid = -1; return; }
        if (hipOccupancyMaxActiveBlocksPerMultiprocessor(&per_cu, (const void*)fwd_kernel, NWAVES * 64, LDS_BYTES) != hipSuccess || per_cu < 1) { fprintf(stderr, "kernel_launch: occupancy query says %d\n", per_cu); }
        (void)hipGetLastError();
        grid = cus;
    }
    if (grid < 0) return;
    (void)hipMemsetAsync((char*)d_ws + WS_CTL, 0, CTL_ZERO_BYTES, stream);
    Args a{};
    a.x_prompt = (const float*)d_in[0]; a.x_sample = (const float*)d_in[1]; a.p_prompt = (const float*)d_in[2]; a.p_sample = (const float*)d_in[3];
    a.norm_pre = (const float*)d_in[4]; a.w_in = (const float*)d_in[5]; a.b_gate = (const float*)d_in[6]; a.w_pool = (const float*)d_in[7]; a.pool_scale = (const float*)d_in[8];
    a.mlstm_norm = (const float*)d_in[9]; a.q_norm = (const float*)d_in[10]; a.k_norm = (const float*)d_in[11]; a.w_out = (const float*)d_in[12]; a.norm_post = (const float*)d_in[13];
    a.w_ple_proj = (const float*)d_in[14]; a.w_ple_gate = (const float*)d_in[15]; a.ple_norm = (const float*)d_in[16];
    a.out = (float*)d_out; a.ws = (unsigned char*)d_ws;
#if MK_ONE_LAUNCH
    a.ph_lo = 0; a.ph_hi = N_PHASES;
    hipLaunchKernelGGL(fwd_kernel, dim3(grid), dim3(NWAVES * 64), LDS_BYTES, stream, a);
#else
    for (int p = 0; p < N_PHASES; ++p) { a.ph_lo = p; a.ph_hi = p + 1; hipLaunchKernelGGL(fwd_kernel, dim3(grid), dim3(NWAVES * 64), LDS_BYTES, stream, a); }
#endif
    const hipError_t le = hipPeekAtLastError();
    if (le != hipSuccess) fprintf(stderr, "kernel_launch: launch failed: %s\n", hipGetErrorName(le));
}
```

```cpp
#include <hip/hip_runtime.h>
#include <cstdio>
#include <cstdint>

#ifndef PROBE_INPROJ
#define PROBE_INPROJ 1
#endif
#ifndef PROBE_ATTN
#define PROBE_ATTN 1
#endif
#ifndef PROBE_MLSTM
#define PROBE_MLSTM 1
#endif
#ifndef PROBE_OUTPROJ
#define PROBE_OUTPROJ 1
#endif
#ifndef PROBE_GATE
#define PROBE_GATE 1
#endif
#ifndef PROBE_SMALLGEMM
#define PROBE_SMALLGEMM 1
#endif
#ifndef PROBE_PRO
#define PROBE_PRO 1
#endif
#ifndef PROBE_X1
#define PROBE_X1 1
#endif
#ifndef PROBE_BAR
#define PROBE_BAR 0
#endif
#ifndef PROBE_MIX
#define PROBE_MIX 1
#endif
#ifndef MK_ONE_LAUNCH
#define MK_ONE_LAUNCH 1
#endif

constexpr int DM = 4096, NTOK = 32768, NPROMPT = 16384, NIN = 12288, NINSRC = 12304, DEPTH = 2, PLE = 256;
constexpr int C_PU = 0, C_PZ = 1024, C_MQ = 2048, C_MK = 3072, C_MV = 4096, C_MO = 5120, C_MZ = 6144, C_AQ = 7168, C_AK = 9216, C_AV = 9728, C_AZ = 10240;
constexpr float EPS = 1e-6f;
constexpr int NWAVES = 8;

constexpr size_t MiB = 1u << 20;
constexpr size_t WS_CTL = 0, CTL_ZERO_BYTES = 1 * MiB;
constexpr size_t WS_ROPE = 1 * MiB;
constexpr size_t WS_ABOUND = 1 * MiB + 768 * 1024;
constexpr size_t WS_WG = 2 * MiB;
constexpr size_t WS_GATES = 3 * MiB;
constexpr size_t WS_WPOOL = 5 * MiB;
constexpr size_t WS_WPROJ = 6 * MiB;
constexpr size_t WS_STATS = 8 * MiB;
constexpr size_t WS_PB = 16 * MiB;
constexpr size_t WS_WOUT = 48 * MiB;
constexpr size_t WS_WGATE = 80 * MiB;
constexpr size_t WS_WIN = 112 * MiB;
constexpr size_t WS_H = 208 * MiB;
constexpr size_t WS_DPOOL = WS_H;
constexpr size_t WS_HF = WS_H + 64 * MiB;
constexpr size_t WS_HB = WS_H + 128 * MiB;
constexpr size_t WS_KC = WS_H + 192 * MiB;
constexpr size_t WS_VC = WS_H + 224 * MiB;
constexpr size_t WS_Y = 464 * MiB;
constexpr size_t WS_ZIN = 720 * MiB;
constexpr size_t WS_YO = WS_ZIN;
constexpr size_t WS_PP = WS_ZIN + 256 * MiB;
constexpr size_t WS_GSC = 1488 * MiB;
constexpr size_t WS_CHS = 1492 * MiB;
constexpr size_t WS_END = 1493 * MiB;

constexpr int RING_BYTES = 131072;
constexpr int LDS_BYTES = 147456;
constexpr int MISC_OFF = LDS_BYTES - 256;

#define LAS __attribute__((address_space(3)))
typedef unsigned short bf16_t;
typedef short bf16x8 __attribute__((ext_vector_type(8)));
typedef short s16x4 __attribute__((ext_vector_type(4)));
typedef float f32x4 __attribute__((ext_vector_type(4)));
typedef float f32x2 __attribute__((ext_vector_type(2)));
typedef float f32x8 __attribute__((ext_vector_type(8)));
typedef float f32x16 __attribute__((ext_vector_type(16)));
typedef unsigned u32x4 __attribute__((ext_vector_type(4)));
typedef unsigned u32x2 __attribute__((ext_vector_type(2)));

__device__ __forceinline__ unsigned cvt_pk_bf16(float lo, float hi) { unsigned r; asm volatile("v_cvt_pk_bf16_f32 %0, %1, %2" : "=v"(r) : "v"(lo), "v"(hi)); return r; }
__device__ __forceinline__ bf16_t f2bf(float f) { return (bf16_t)(cvt_pk_bf16(f, 0.f) & 0xffffu); }
__device__ __forceinline__ float bf2f(bf16_t b) { return __uint_as_float(((unsigned)b) << 16); }
__device__ __forceinline__ float bflo(unsigned w) { return __uint_as_float(w << 16); }
__device__ __forceinline__ float bfhi(unsigned w) { return __uint_as_float(w & 0xffff0000u); }
template <int K> __device__ __forceinline__ float swz_xor(float v) { static_assert(K >= 1 && K <= 16, "ds_swizzle reaches 32 lanes"); return __int_as_float(__builtin_amdgcn_ds_swizzle(__float_as_int(v), 0x1F | (K << 10))); }
template <int K> __device__ __forceinline__ float addx(float v) {
    if constexpr (K == 32) { auto rr = __builtin_amdgcn_permlane32_swap(__float_as_uint(v), __float_as_uint(v), false, false); return __uint_as_float(rr[0]) + __uint_as_float(rr[1]); }
    else return v + swz_xor<K>(v);
}
__device__ __forceinline__ float wave_sum(float v) { v = addx<1>(v); v = addx<2>(v); v = addx<4>(v); v = addx<8>(v); v = addx<16>(v); return addx<32>(v); }
__device__ __forceinline__ float shfl_from(float v, int srclane) { return __int_as_float(__builtin_amdgcn_ds_bpermute(srclane << 2, __float_as_int(v))); }
__device__ __forceinline__ int opaque_tid() { int t = threadIdx.x; asm volatile("" : "+v"(t)); return t; }
__device__ __forceinline__ float fast_exp(float x) { return __builtin_amdgcn_exp2f(x * 1.4426950408889634f); }
__device__ __forceinline__ float sigmoidf_(float x) { return __builtin_amdgcn_rcpf(1.f + fast_exp(-x)); }
__device__ __forceinline__ float siluf_(float x) { return x * sigmoidf_(x); }
#define LDS_WAIT() asm volatile("s_waitcnt lgkmcnt(0)" ::: "memory")
#define VM_WAIT() asm volatile("s_waitcnt vmcnt(0)" ::: "memory")
#define SBAR() __builtin_amdgcn_sched_barrier(0)

#define XB_TMO      128
#define XB_XCNT(j)  (256  + 64 * (j))
#define XB_XSUB(j)  (1280 + 64 * (j))
#define XB_XGEN(j)  (2304 + 64 * (j))
#define XB_TOP      3328
#define XB_TOPGEN   3392
#define XCD_BAR_WORDS 3456
#define XB_SPIN_CAP (1u << 22)
__device__ __forceinline__ unsigned xb_ld(unsigned* p)              { return __hip_atomic_load(p, __ATOMIC_RELAXED, __HIP_MEMORY_SCOPE_AGENT); }
__device__ __forceinline__ unsigned xb_add(unsigned* p, unsigned v) { return __hip_atomic_fetch_add(p, v, __ATOMIC_RELAXED, __HIP_MEMORY_SCOPE_AGENT); }
__device__ __forceinline__ unsigned xb_xcc_id() { return (unsigned)__builtin_amdgcn_s_getreg((3 << 11) | 20) & 0xFu; }
#define XB_SPIN(cond, bar) do { unsigned _sp = 0; while (cond) { __builtin_amdgcn_s_sleep(1); \
    if ((++_sp & 255u) == 0u) { if (xb_ld(&(bar)[XB_TMO])) break; if (_sp > XB_SPIN_CAP) { atomicAdd(&(bar)[XB_TMO], 1u); break; } } } } while (0)
struct XcdBarrier { unsigned* bar; unsigned x; volatile LAS unsigned* st; };
__device__ __forceinline__ XcdBarrier xcd_barrier_post(unsigned* bar, volatile LAS unsigned* st) {
    XcdBarrier b; b.bar = bar; b.x = xb_xcc_id(); b.st = st;
    if (threadIdx.x == 0) (void)xb_add(&bar[XB_XCNT(b.x)], 1u);
    return b;
}
__device__ __forceinline__ void xcd_barrier_complete(unsigned* bar, unsigned x, unsigned& nloc, unsigned& nx) {
    const unsigned G = gridDim.x * gridDim.y * gridDim.z;
    unsigned sum, cnt, mine, sp = 0u;
    for (;;) {
        sum = 0u; cnt = 0u; mine = 0u;
#pragma unroll
        for (unsigned j = 0; j < 16; ++j) { const unsigned c = xb_ld(&bar[XB_XCNT(j)]); sum += c; cnt += (c > 0u) ? 1u : 0u; mine = (j == x) ? c : mine; }
        if (sum == G) break;
        __builtin_amdgcn_s_sleep(1);
        if ((++sp & 255u) == 0u) { if (xb_ld(&bar[XB_TMO])) break; if (sp > XB_SPIN_CAP) { atomicAdd(&bar[XB_TMO], 1u); break; } }
    }
    nloc = mine > 0u ? mine : 1u; nx = cnt > 0u ? cnt : 1u;
}
__device__ __forceinline__ void xcd_barrier(const XcdBarrier& b) {
    asm volatile("s_waitcnt vmcnt(0)" ::: "memory");
    __syncthreads();
    if (threadIdx.x == 0) {
        unsigned* bar = b.bar;
        __builtin_amdgcn_s_waitcnt(0);
        unsigned nloc = b.st[0], nx = b.st[1];
        if (nloc == 0u) { xcd_barrier_complete(bar, b.x, nloc, nx); b.st[0] = nloc; b.st[1] = nx; }
        const unsigned old = xb_add(&bar[XB_XSUB(b.x)], 1u);
        const unsigned gen = old / nloc;
        if (old + 1u == (gen + 1u) * nloc) {
            __builtin_amdgcn_fence(__ATOMIC_RELEASE, "agent");
            asm volatile("s_waitcnt vmcnt(0)" ::: "memory");
            const unsigned og = xb_add(&bar[XB_TOP], 1u);
            const unsigned tg = og / nx;
            if (og + 1u == (tg + 1u) * nx) xb_add(&bar[XB_TOPGEN], 1u);
            else XB_SPIN(xb_ld(&bar[XB_TOPGEN]) == tg, bar);
            __builtin_amdgcn_fence(__ATOMIC_ACQUIRE, "agent");
            xb_add(&bar[XB_XGEN(b.x)], 1u);
            asm volatile("s_waitcnt vmcnt(0)" ::: "memory");
        } else {
            XB_SPIN(xb_ld(&bar[XB_XGEN(b.x)]) == gen, bar);
            __builtin_amdgcn_fence(__ATOMIC_ACQUIRE, "agent");
            asm volatile("s_waitcnt vmcnt(0)" ::: "memory");
        }
    }
    __syncthreads();
}

#ifndef PG8_SP2
#define PG8_SP2 true
#endif
namespace pg8 {
constexpr int BM = 256, BK = 64, HALF = 128, HTB = HALF * BK * 2, STAGE_BYTES = 8 * HTB, NXCD = 8, WGM = 8;
__host__ __device__ __forceinline__ int lds_byte(int r, int c) { const int st = (r >> 4) * 2 + (c >> 5), rr = r & 15, cc = c & 31, ob = rr * 64 + cc * 2; return st * 1024 + (ob ^ (((ob >> 9) & 1) << 5)); }
__host__ __device__ __forceinline__ void stage_rc(int b, int& R, int& C) { const int st = b / 1024, sb = b % 1024, swz = sb ^ (((sb >> 9) & 1) << 5); R = (st >> 1) * 16 + swz / 64; C = (st & 1) * 32 + (swz % 64) / 2; }
__host__ __device__ __forceinline__ int perm32(int rho) { const int n = rho >> 4, i = rho & 15; return 8 * (i >> 2) + 4 * n + (i & 3); }
struct Unit { int pm, pn; };
struct Gemm { const bf16_t* A; const bf16_t* Bt; int M, N, K, lda, ldb, a_pn_off; };
struct StaticOrder {
    int nM, nN, nwg, G, c;
    __host__ __device__ void init(int M, int N, int G_, int c_) { nM = M / BM; nN = N / BM; nwg = nM * nN; G = G_; c = c_; }
    __host__ __device__ bool next(int i, Unit& u) const {
        const long L = (long)i * G + c; if (L >= nwg) return false;
        int wgid = (int)L; { const int q = nwg / NXCD, r = nwg % NXCD, xcd = wgid % NXCD, off = wgid / NXCD; wgid = (xcd < r ? xcd * (q + 1) : r * (q + 1) + (xcd - r) * q) + off; }
        const int nig = WGM * nN, gid = wgid / nig, fm = gid * WGM, gsz = (nM - fm) < WGM ? (nM - fm) : WGM;
        u.pm = fm + ((wgid % nig) % gsz); u.pn = (wgid % nig) / gsz; return true;
    }
};
template <class Epi>
__device__ __forceinline__ void gemm_phase(LAS unsigned char* lds, const Gemm g, const StaticOrder& S, const Epi& E) {
    const int tid = opaque_tid(), wid = __builtin_amdgcn_readfirstlane(tid >> 6), lane = tid & 63, wr = wid >> 2, wc = wid & 3, fr = lane & 15, fq = lane >> 4;
    const int K = g.K, nt = K / BK;
    unsigned voffA[2], voffB[2];
#pragma unroll
    for (int i = 0; i < 2; ++i) { int R, C; stage_rc(tid * 16 + i * 8192, R, C); const int Rb = (R & ~31) + perm32(R & 31);
        voffA[i] = (unsigned)(R * g.lda + C) * 2u; voffB[i] = (unsigned)(Rb * g.ldb + C) * 2u; }
    const size_t kstep = (size_t)(BK * 2);
    const size_t hstepA = (size_t)HALF * g.lda * 2, hstepB = (size_t)HALF * g.ldb * 2;
    const size_t tstepA = 2 * hstepA, tstepB = 2 * hstepB;
    const unsigned ldsw = (unsigned)wid * 1024u;
    const int aoff = lds_byte(wr * 64 + fr, fq * 8), boff = lds_byte(wc * 32 + fr, fq * 8);
#define PG8_SA(b, h) (((b) * 2 + (h)) * HTB)
#define PG8_SB(b, h) ((4 + (b) * 2 + (h)) * HTB)
#define PG8_STAGE(bufoff, gbase, voff) do { _Pragma("unroll") for (int _i = 0; _i < 2; ++_i) \
        __builtin_amdgcn_global_load_lds((const unsigned*)((const char*)(gbase) + (voff)[_i]), (LAS unsigned*)(lds + (bufoff) + ldsw + _i * 8192), 16, 0, 0); } while (0)
#define PG8_LDA(dst, b, h) do { _Pragma("unroll") for (int m = 0; m < 4; ++m) _Pragma("unroll") for (int k = 0; k < 2; ++k) dst[m][k] = *(const LAS bf16x8*)(lds + PG8_SA(b, h) + aoff + m * 2048 + k * 1024); } while (0)
#define PG8_LDB(dst, b, h) do { _Pragma("unroll") for (int n = 0; n < 2; ++n) _Pragma("unroll") for (int k = 0; k < 2; ++k) dst[n][k] = *(const LAS bf16x8*)(lds + PG8_SB(b, h) + boff + n * 2048 + k * 1024); } while (0)
#define PG8_MMA(ai, bj, At, Bt) do { __builtin_amdgcn_s_setprio(1); _Pragma("unroll") for (int m = 0; m < 4; ++m) _Pragma("unroll") for (int n = 0; n < 2; ++n) _Pragma("unroll") for (int k = 0; k < 2; ++k) \
        acc[ai][bj][m][n] = __builtin_amdgcn_mfma_f32_16x16x32_bf16(Bt[n][k], At[m][k], acc[ai][bj][m][n], 0, 0, 0); __builtin_amdgcn_s_setprio(0); } while (0)
#define PG8_WAIT_V(n) asm volatile("s_waitcnt vmcnt(" #n ")" ::: "memory")
#define PG8_WAIT_L(n) asm volatile("s_waitcnt lgkmcnt(" #n ")" ::: "memory")
#define PG8_BAR __builtin_amdgcn_s_barrier()
#define PG8_SCHED __builtin_amdgcn_sched_barrier(0)
    Unit cur, nxt; int ui = 0;
    if (!S.next(0, cur)) return;
    f32x4 acc[2][2][4][2];
#pragma unroll
    for (int a = 0; a < 2; ++a)
#pragma unroll
        for (int b = 0; b < 2; ++b)
#pragma unroll
            for (int m = 0; m < 4; ++m)
#pragma unroll
                for (int n = 0; n < 2; ++n) acc[a][b][m][n] = (f32x4){0.f, 0.f, 0.f, 0.f};
    bf16x8 At[4][2], B0[2][2], B1[2][2];
    const char* cA = (const char*)g.A + (size_t)cur.pm * tstepA + (size_t)cur.pn * g.a_pn_off * 2; const char* cB = (const char*)g.Bt + (size_t)cur.pn * tstepB;
    if constexpr (PG8_SP2) {
        PG8_STAGE(PG8_SB(0, 0), cB, voffB); PG8_STAGE(PG8_SB(0, 1), cB + hstepB, voffB); PG8_STAGE(PG8_SA(0, 0), cA, voffA); PG8_STAGE(PG8_SA(0, 1), cA + hstepA, voffA);
        if (wr == 1) PG8_BAR;
        PG8_WAIT_V(2); PG8_BAR;
        PG8_STAGE(PG8_SB(1, 0), cB + kstep, voffB); PG8_STAGE(PG8_SA(1, 0), cA + kstep, voffA); PG8_STAGE(PG8_SB(1, 1), cB + hstepB + kstep, voffB);
        PG8_WAIT_V(6); PG8_BAR;
    } else {
    PG8_STAGE(PG8_SB(0, 0), cB, voffB); PG8_STAGE(PG8_SA(0, 0), cA, voffA); PG8_STAGE(PG8_SB(0, 1), cB + hstepB, voffB); PG8_STAGE(PG8_SA(0, 1), cA + hstepA, voffA);
    if (wr == 1) PG8_BAR;
    PG8_WAIT_V(4); PG8_BAR;
    PG8_STAGE(PG8_SB(1, 0), cB + kstep, voffB); PG8_STAGE(PG8_SA(1, 0), cA + kstep, voffA); PG8_STAGE(PG8_SB(1, 1), cB + hstepB + kstep, voffB);
    PG8_WAIT_V(6); PG8_BAR;
    }
    for (;;) {
        const bool has_next = S.next(ui + 1, nxt);
        const char* nA = has_next ? (const char*)g.A + (size_t)nxt.pm * tstepA + (size_t)nxt.pn * g.a_pn_off * 2 : cA; const char* nB = has_next ? (const char*)g.Bt + (size_t)nxt.pn * tstepB : cB;
        for (int t = 0; t < nt; t += 2) {
            const bool last = (t == nt - 2);
            const char* a1 = cA + (size_t)(t + 1) * kstep;
            const char* a2 = last ? nA : cA + (size_t)(t + 2) * kstep; const char* b2 = last ? nB : cB + (size_t)(t + 2) * kstep;
            const char* a3 = a2 + kstep; const char* b3 = b2 + kstep;
            if constexpr (PG8_SP2) {
            PG8_LDB(B0, 0, 0); PG8_LDB(B1, 0, 1); PG8_SCHED; PG8_LDA(At, 0, 0); PG8_STAGE(PG8_SA(1, 1), a1 + hstepA, voffA);
            PG8_WAIT_V(8); PG8_WAIT_L(0); PG8_BAR; PG8_MMA(0, 0, At, B0); PG8_MMA(0, 1, At, B1); PG8_BAR; PG8_SCHED;
            PG8_LDA(At, 0, 1); PG8_STAGE(PG8_SB(0, 0), b2, voffB); PG8_STAGE(PG8_SB(0, 1), b2 + hstepB, voffB); PG8_STAGE(PG8_SA(0, 0), a2, voffA);
            PG8_WAIT_V(8); PG8_WAIT_L(0); PG8_BAR; PG8_MMA(1, 0, At, B0); PG8_MMA(1, 1, At, B1); PG8_BAR; PG8_SCHED;
            PG8_LDB(B0, 1, 0); PG8_LDB(B1, 1, 1); PG8_SCHED; PG8_LDA(At, 1, 0); PG8_STAGE(PG8_SA(0, 1), a2 + hstepA, voffA);
            PG8_WAIT_V(8); PG8_WAIT_L(0); PG8_BAR; PG8_MMA(0, 0, At, B0); PG8_MMA(0, 1, At, B1); PG8_BAR; PG8_SCHED;
            PG8_LDA(At, 1, 1); PG8_STAGE(PG8_SB(1, 0), b3, voffB); PG8_STAGE(PG8_SB(1, 1), b3 + hstepB, voffB); PG8_STAGE(PG8_SA(1, 0), a3, voffA);
            PG8_WAIT_V(8); PG8_WAIT_L(0); PG8_BAR; PG8_MMA(1, 0, At, B0); PG8_MMA(1, 1, At, B1); PG8_BAR; PG8_SCHED;
            } else {
            PG8_LDB(B0, 0, 0); PG8_SCHED; PG8_LDA(At, 0, 0); PG8_STAGE(PG8_SA(1, 1), a1 + hstepA, voffA);
            PG8_WAIT_L(8); PG8_BAR; PG8_WAIT_L(0); PG8_MMA(0, 0, At, B0); PG8_BAR; PG8_SCHED;
            PG8_LDB(B1, 0, 1); PG8_STAGE(PG8_SB(0, 0), b2, voffB);
            PG8_BAR; PG8_WAIT_L(0); PG8_MMA(0, 1, At, B1); PG8_BAR;
            PG8_LDA(At, 0, 1); PG8_STAGE(PG8_SA(0, 0), a2, voffA);
            PG8_BAR; PG8_WAIT_L(0); PG8_MMA(1, 0, At, B0); PG8_BAR; PG8_SCHED;
            PG8_STAGE(PG8_SB(0, 1), b2 + hstepB, voffB);
            PG8_WAIT_V(6); PG8_BAR; PG8_MMA(1, 1, At, B1); PG8_BAR;
            PG8_LDB(B0, 1, 0); PG8_SCHED; PG8_LDA(At, 1, 0); PG8_STAGE(PG8_SA(0, 1), a2 + hstepA, voffA);
            PG8_WAIT_L(8); PG8_BAR; PG8_WAIT_L(0); PG8_MMA(0, 0, At, B0); PG8_BAR; PG8_SCHED;
            PG8_LDB(B1, 1, 1); PG8_STAGE(PG8_SB(1, 0), b3, voffB);
            PG8_BAR; PG8_WAIT_L(0); PG8_MMA(0, 1, At, B1); PG8_BAR;
            PG8_LDA(At, 1, 1); PG8_STAGE(PG8_SA(1, 0), a3, voffA);
            PG8_BAR; PG8_WAIT_L(0); PG8_MMA(1, 0, At, B0); PG8_BAR; PG8_SCHED;
            PG8_STAGE(PG8_SB(1, 1), b3 + hstepB, voffB);
            PG8_WAIT_V(6); PG8_BAR; PG8_MMA(1, 1, At, B1); PG8_BAR;
            }
        }
        if (wr == 0) PG8_BAR;
        E(acc, cur, wr, wc, fr, fq);
        if (!has_next) break;
#pragma unroll
        for (int a = 0; a < 2; ++a)
#pragma unroll
            for (int b = 0; b < 2; ++b)
#pragma unroll
                for (int m = 0; m < 4; ++m)
#pragma unroll
                    for (int n = 0; n < 2; ++n) acc[a][b][m][n] = (f32x4){0.f, 0.f, 0.f, 0.f};
        cur = nxt; cA = nA; cB = nB; ++ui;
        if (wr == 1) PG8_BAR;
    }
    PG8_WAIT_V(0);
    PG8_BAR;
#undef PG8_SA
#undef PG8_SB
#undef PG8_STAGE
#undef PG8_LDA
#undef PG8_LDB
#undef PG8_MMA
#undef PG8_WAIT_V
#undef PG8_WAIT_L
#undef PG8_BAR
#undef PG8_SCHED
}
}

template <int MODE> struct Epi {
    bf16_t* O; int ldc; const float* vec; const bf16_t* aux; int ldaux; float* stats;
    __device__ __forceinline__ void operator()(const f32x4 (&acc)[2][2][4][2], const pg8::Unit& u, int wr, int wc, int fr, int fq) const {
        using namespace pg8;
        const int row0 = u.pm * BM + wr * 64 + fr, col0 = u.pn * BM + wc * 32 + 8 * fq;
        int act = 0;
        if (MODE == 0) { const int t = u.pn; act = ((t >= 4 && t < 8) || (t >= 24 && t < 28) || t >= 40) ? 1 : ((t >= 20 && t < 24) ? 2 : ((t >= 8 && t < 12) ? 3 : 0)); }
#pragma unroll
        for (int ai = 0; ai < 2; ++ai)
#pragma unroll
            for (int m = 0; m < 4; ++m) {
                const int row = row0 + ai * HALF + m * 16;
                bf16_t* rowp = O + (size_t)row * ldc + col0;
                float ss = 0.f;
#pragma unroll
                for (int bj = 0; bj < 2; ++bj) {
                    f32x4 v0 = acc[ai][bj][m][0], v1 = acc[ai][bj][m][1];
                    if (MODE == 0) {
                        if (act == 1) {
#pragma unroll
                            for (int j = 0; j < 4; ++j) { v0[j] = siluf_(v0[j]); v1[j] = siluf_(v1[j]); }
                        } else if (act == 2) {
#pragma unroll
                            for (int j = 0; j < 4; ++j) { v0[j] = sigmoidf_(v0[j]); v1[j] = sigmoidf_(v1[j]); }
                        } else if (act == 3) { v0 = v0 * 0.0625f; v1 = v1 * 0.0625f; }
                    }
                    if (MODE == 1) {
                        const u32x4 z = *(const u32x4*)(aux + (size_t)row * ldaux + col0 + bj * HALF);
                        v0 = v0 * *(const f32x4*)(vec + col0 + bj * HALF); v1 = v1 * *(const f32x4*)(vec + col0 + bj * HALF + 4);
                        v0[0] *= bflo(z.x); v0[1] *= bfhi(z.x); v0[2] *= bflo(z.y); v0[3] *= bfhi(z.y);
                        v1[0] *= bflo(z.z); v1[1] *= bfhi(z.z); v1[2] *= bflo(z.w); v1[3] *= bfhi(z.w);
                    }
                    if (MODE == 4) {
                        const u32x4 z = *(const u32x4*)(aux + (size_t)row * ldaux + col0 + bj * HALF);
#pragma unroll
                        for (int j = 0; j < 4; ++j) { v0[j] = sigmoidf_(v0[j]); v1[j] = sigmoidf_(v1[j]); }
                        v0[0] *= bflo(z.x); v0[1] *= bfhi(z.x); v0[2] *= bflo(z.y); v0[3] *= bfhi(z.y);
                        v1[0] *= bflo(z.z); v1[1] *= bfhi(z.z); v1[2] *= bflo(z.w); v1[3] *= bfhi(z.w);
                    }
                    if (MODE == 3 || MODE == 4) ss += (v0[0] * v0[0] + v0[1] * v0[1]) + (v0[2] * v0[2] + v0[3] * v0[3]) + (v1[0] * v1[0] + v1[1] * v1[1]) + (v1[2] * v1[2] + v1[3] * v1[3]);
                    u32x4 w; w.x = cvt_pk_bf16(v0[0], v0[1]); w.y = cvt_pk_bf16(v0[2], v0[3]); w.z = cvt_pk_bf16(v1[0], v1[1]); w.w = cvt_pk_bf16(v1[2], v1[3]);
                    *(u32x4*)(rowp + bj * HALF) = w;
                }
                if (MODE == 3 || MODE == 4) {
                    ss = addx<16>(ss); ss = addx<32>(ss);
                    if (fq == 0) stats[(size_t)row * 64 + u.pn * 4 + wc] = ss;
                }
            }
    }
};

namespace att {
constexpr int D = 128, NW = 8, QBLK = 32, KVBLK = 64;
constexpr float SCALE = 0.088388347648318440f;
constexpr float THR = 8.f;
constexpr int LDQ = NIN, LDK = 128, LDV = NIN;
constexpr size_t SHM_V = KVBLK * D * 2, SHM_K = KVBLK * D * 2;
#define KSWZ(row, colB) ((row) * 256 + ((colB) ^ (((row) & 7) << 4)))
__device__ __forceinline__ int crow(int r, int hi) { return (r & 3) + 8 * (r >> 2) + 4 * hi; }
constexpr float THRL = THR * 1.4426950408889634f;
__device__ __forceinline__ void partialSM(f32x16& p0, f32x16& p1, float& m_reg, float& mn, float& alpha, bool noshift) {
  if (noshift) alpha = 1.f;
  else {
  float pmax = p0[0]; for (int r = 1; r < 16; ++r) pmax = fmaxf(pmax, p0[r]); for (int r = 0; r < 16; ++r) pmax = fmaxf(pmax, p1[r]);
  { auto rr = __builtin_amdgcn_permlane32_swap(__float_as_uint(pmax), __float_as_uint(pmax), false, false);
    pmax = fmaxf(__uint_as_float(rr[0]), __uint_as_float(rr[1])); }
  if (__builtin_expect(__all(pmax - m_reg <= THRL), 1)) { mn = m_reg; alpha = 1.f; }
  else { mn = fmaxf(m_reg, pmax); alpha = __builtin_amdgcn_exp2f(m_reg - mn); m_reg = mn; }
  for (int r = 0; r < 16; ++r) p0[r] -= mn; for (int r = 0; r < 16; ++r) p1[r] -= mn;
  }
  for (int r = 0; r < 16; ++r) p0[r] = __builtin_amdgcn_exp2f(p0[r]);
}
template <bool BOTH = false>
__device__ __forceinline__ void finishSM(f32x16& p0, f32x16& p1, float alpha, float& l_reg, bf16x8& pa0, bf16x8& pa1, bf16x8& pa2, bf16x8& pa3) {
  if (BOTH) { for (int r = 0; r < 16; ++r) p0[r] = __builtin_amdgcn_exp2f(p0[r]); }
  for (int r = 0; r < 16; ++r) p1[r] = __builtin_amdgcn_exp2f(p1[r]);
  float ps = 0; for (int r = 0; r < 16; ++r) ps += p0[r]; for (int r = 0; r < 16; ++r) ps += p1[r];
  { auto rr = __builtin_amdgcn_permlane32_swap(__float_as_uint(ps), __float_as_uint(ps), false, false);
    ps = __uint_as_float(rr[0]) + __uint_as_float(rr[1]); }
  l_reg = l_reg * alpha + ps;
#define PK4(P, BASE, OUT) do { unsigned a0 = cvt_pk_bf16(P[BASE + 0], P[BASE + 1]), a1 = cvt_pk_bf16(P[BASE + 2], P[BASE + 3]);   \
    unsigned b0 = cvt_pk_bf16(P[BASE + 4], P[BASE + 5]), b1 = cvt_pk_bf16(P[BASE + 6], P[BASE + 7]);                              \
    u32x4 w = {a0, a1, b0, b1}; OUT = *reinterpret_cast<bf16x8*>(&w); } while (0)
  PK4(p0, 0, pa0); PK4(p0, 8, pa1); PK4(p1, 0, pa2); PK4(p1, 8, pa3);
#undef PK4
}
__device__ __forceinline__ void qkt(f32x16& p0, f32x16& p1, const bf16_t* Ks, const bf16x8* qr, int r32, int hi) {
  p0 = f32x16{}; p1 = f32x16{};
  for (int d0 = 0; d0 < 8; ++d0) { int cb = (d0 * 16 + hi * 8) * 2;
    bf16x8 b0 = *reinterpret_cast<const bf16x8*>((const char*)Ks + KSWZ(r32, cb));
    bf16x8 b1 = *reinterpret_cast<const bf16x8*>((const char*)Ks + KSWZ(32 + r32, cb));
    p0 = __builtin_amdgcn_mfma_f32_32x32x16_bf16(b0, qr[d0], p0, 0, 0, 0);
    p1 = __builtin_amdgcn_mfma_f32_32x32x16_bf16(b1, qr[d0], p1, 0, 0, 0); }
}
__device__ __forceinline__ int v_st(int k, int c) { const int kk = (k & ~0xC) | ((k & 4) << 1) | ((k & 8) >> 1); return ((kk >> 3) * 4 + (c >> 5)) * 512 + ((kk & 7) * 32 + (c & 31)) * 2; }
__device__ __forceinline__ int v_rd_base(int lane) { return ((lane & 3) << 3) | (((lane >> 2) & 3) << 6) | (((lane >> 4) & 1) << 5) | (((lane >> 5) & 1) << 8); }
constexpr int v_rd_off(int d0, int ks, int half) { return d0 * 512 + ks * 4096 + half * 2048; }
template <int OFF> __device__ __forceinline__ s16x4 tr_read(int vb) {
  s16x4 r; asm volatile("ds_read_b64_tr_b16 %0, %1 offset:%2" : "=&v"(r) : "v"(vb), "i"(OFF) : "memory"); return r;
}
template <int D0> __device__ __forceinline__ void pv_issue(s16x4 (&r)[8], int vb) {
  r[0] = tr_read<v_rd_off(D0, 0, 0)>(vb); r[1] = tr_read<v_rd_off(D0, 0, 1)>(vb); r[2] = tr_read<v_rd_off(D0, 1, 0)>(vb); r[3] = tr_read<v_rd_off(D0, 1, 1)>(vb);
  r[4] = tr_read<v_rd_off(D0, 2, 0)>(vb); r[5] = tr_read<v_rd_off(D0, 2, 1)>(vb); r[6] = tr_read<v_rd_off(D0, 3, 0)>(vb); r[7] = tr_read<v_rd_off(D0, 3, 1)>(vb);
}
__device__ __forceinline__ void pv_mma(f32x16& od, const s16x4 (&r)[8], bf16x8 pa0, bf16x8 pa1, bf16x8 pa2, bf16x8 pa3) {
#define PK(L, H) (bf16x8){L[0], L[1], L[2], L[3], H[0], H[1], H[2], H[3]}
  od = __builtin_amdgcn_mfma_f32_32x32x16_bf16(pa0, PK(r[0], r[1]), od, 0, 0, 0);
  od = __builtin_amdgcn_mfma_f32_32x32x16_bf16(pa1, PK(r[2], r[3]), od, 0, 0, 0);
  od = __builtin_amdgcn_mfma_f32_32x32x16_bf16(pa2, PK(r[4], r[5]), od, 0, 0, 0);
  od = __builtin_amdgcn_mfma_f32_32x32x16_bf16(pa3, PK(r[6], r[7]), od, 0, 0, 0);
#undef PK
}
__device__ __forceinline__ void pv_d0(f32x16* o, int vb, bf16x8 pa0, bf16x8 pa1, bf16x8 pa2, bf16x8 pa3) {
  s16x4 ra[8], rb[8];
  pv_issue<0>(ra, vb); pv_issue<1>(rb, vb);
  asm volatile("s_waitcnt lgkmcnt(8)" ::: "memory"); SBAR(); pv_mma(o[0], ra, pa0, pa1, pa2, pa3); SBAR();
  pv_issue<2>(ra, vb);
  asm volatile("s_waitcnt lgkmcnt(8)" ::: "memory"); SBAR(); pv_mma(o[1], rb, pa0, pa1, pa2, pa3); SBAR();
  pv_issue<3>(rb, vb);
  asm volatile("s_waitcnt lgkmcnt(8)" ::: "memory"); SBAR(); pv_mma(o[2], ra, pa0, pa1, pa2, pa3); SBAR();
  asm volatile("s_waitcnt lgkmcnt(0)" ::: "memory"); SBAR(); pv_mma(o[3], rb, pa0, pa1, pa2, pa3);
}
template <bool NOSHIFT>
__device__ __forceinline__ void attn_unit(const bf16_t* __restrict__ Qb, const bf16_t* __restrict__ Kh, const bf16_t* __restrict__ Vh,
                                          const bf16_t* __restrict__ Zb, bf16_t* __restrict__ Yb, int seq, char* lds, LAS unsigned char* ldsl) {
  const int tid = opaque_tid();
  const int wid = tid >> 6, lane = tid & 63, r32 = lane & 31, hi = lane >> 5, wu = __builtin_amdgcn_readfirstlane(wid);
  char* V_lds = lds; char* K_lds = lds + 4 * SHM_V;
  float* ws = (float*)(lds + 4 * SHM_V + 4 * SHM_K) + wid * 64; float* li_l = ws; float* al_l = ws + 32;
  float m_reg = -1e30f, l_reg = 0; f32x16 o[4] = {}; bf16x8 qr[8];
  const bf16_t* Qw = Qb + (long)(wid * QBLK + r32) * LDQ + hi * 8;
#pragma unroll
  for (int d0 = 0; d0 < 8; ++d0) qr[d0] = *reinterpret_cast<const bf16x8*>(Qw + d0 * 16);
  const int vb0 = (int)(uintptr_t)V_lds + v_rd_base(lane);
  unsigned kgo0, kgo1, vgo0;
  { const int p = lane & 15, ra = 8 * wu + (lane >> 4), rb = ra + 4;
    kgo0 = (unsigned)(ra * LDK * 2 + ((p ^ (ra & 7)) << 4)); kgo1 = (unsigned)(rb * LDK * 2 + ((p ^ (rb & 7)) << 4));
    const int kk = 8 * wu + ((lane & 31) >> 2), k = kk;
    vgo0 = (unsigned)((k * LDV + 32 * (lane >> 5) + 8 * (lane & 3)) * 2); }
#define ADMA(t) do { const int b_ = (t) & 3; const char* kp_ = (const char*)Kh + (size_t)(t) * (KVBLK * LDK * 2); const char* vp_ = (const char*)Vh + (size_t)(t) * ((size_t)KVBLK * LDV * 2); \
    LAS unsigned char* kd_ = ldsl + 4 * SHM_V + b_ * SHM_K + wu * 2048; LAS unsigned char* vd_ = ldsl + b_ * SHM_V + wu * 2048; \
    __builtin_amdgcn_global_load_lds((const unsigned*)(kp_ + kgo0), (LAS unsigned*)kd_, 16, 0, 0); \
    __builtin_amdgcn_global_load_lds((const unsigned*)(kp_ + kgo1), (LAS unsigned*)(kd_ + 1024), 16, 0, 0); \
    __builtin_amdgcn_global_load_lds((const unsigned*)(vp_ + vgo0), (LAS unsigned*)vd_, 16, 0, 0); \
    __builtin_amdgcn_global_load_lds((const unsigned*)(vp_ + vgo0 + 128), (LAS unsigned*)(vd_ + 1024), 16, 0, 0); } while (0)
#define AWAIT4() asm volatile("s_waitcnt vmcnt(4)" ::: "memory")
#define AWAIT0() asm volatile("s_waitcnt vmcnt(0)" ::: "memory")
#define KBUF(t) ((bf16_t*)(K_lds + ((t) & 3) * SHM_K))
#define VBUF(t) (vb0 + ((t) & 3) * (int)SHM_V)
#define RESC(a) do { if (!NOSHIFT && __any((a) < 1.f)) { if (hi == 0) al_l[r32] = (a); asm volatile("s_waitcnt lgkmcnt(0)" ::: "memory"); \
    for (int d = 0; d < 4; ++d) for (int r = 0; r < 16; ++r) o[d][r] *= al_l[crow(r, hi)]; } } while (0)
  f32x16 pA0, pA1, pB0, pB1; float mnA, mnB, alA, alB; bf16x8 pa0, pa1, pa2, pa3; const int NT = seq / KVBLK;
  constexpr bool fixs = NOSHIFT;
  ADMA(0); ADMA(1);
  AWAIT4(); __syncthreads();
  qkt(pA0, pA1, KBUF(0), qr, r32, hi); if (NOSHIFT) alA = 1.f; else partialSM(pA0, pA1, m_reg, mnA, alA, false);
  ADMA(2);
  AWAIT4(); __syncthreads();
  for (int j = 1; j + 1 < NT; j += 2) {
    SBAR(); qkt(pB0, pB1, KBUF(j), qr, r32, hi);
    finishSM<NOSHIFT>(pA0, pA1, alA, l_reg, pa0, pa1, pa2, pa3); SBAR();
    ADMA(j + 2); SBAR();
    pv_d0(o, VBUF(j - 1), pa0, pa1, pa2, pa3); if (NOSHIFT) alB = 1.f; else partialSM(pB0, pB1, m_reg, mnB, alB, false);
    AWAIT4();
    RESC(alB); __syncthreads();
    SBAR(); qkt(pA0, pA1, KBUF(j + 1), qr, r32, hi);
    finishSM<NOSHIFT>(pB0, pB1, alB, l_reg, pa0, pa1, pa2, pa3); SBAR();
    if (j + 3 < NT) { ADMA(j + 3); } SBAR();
    pv_d0(o, VBUF(j), pa0, pa1, pa2, pa3); if (NOSHIFT) alA = 1.f; else partialSM(pA0, pA1, m_reg, mnA, alA, false);
    if (j + 3 < NT) AWAIT4(); else AWAIT0();
    RESC(alA); __syncthreads();
  }
  SBAR(); qkt(pB0, pB1, KBUF(NT - 1), qr, r32, hi);
  finishSM<NOSHIFT>(pA0, pA1, alA, l_reg, pa0, pa1, pa2, pa3); SBAR();
  pv_d0(o, VBUF(NT - 2), pa0, pa1, pa2, pa3); if (NOSHIFT) alB = 1.f; else partialSM(pB0, pB1, m_reg, mnB, alB, false);
  __syncthreads(); RESC(alB);
  finishSM<NOSHIFT>(pB0, pB1, alB, l_reg, pa0, pa1, pa2, pa3); SBAR();
  const bf16_t* Zw = Zb + (long)(wid * QBLK) * NIN; bf16_t* Yw = Yb + (long)(wid * QBLK) * DM;
  u32x4 zg[8];
#pragma unroll
  for (int e = 0; e < 8; ++e) { const int idx = lane + 64 * e, row = idx >> 4, ch = idx & 15; zg[e] = *(const u32x4*)(Zw + (long)row * NIN + ch * 8); }
  SBAR();
  pv_d0(o, VBUF(NT - 1), pa0, pa1, pa2, pa3);
  if (hi == 0) li_l[r32] = l_reg; asm volatile("s_waitcnt lgkmcnt(0)" ::: "memory");
  float rli[16];
#pragma unroll
  for (int r = 0; r < 16; ++r) rli[r] = __builtin_amdgcn_rcpf(li_l[crow(r, hi)]);
  char* Ol = K_lds + wid * 8192;
#pragma unroll
  for (int r = 0; r < 16; ++r) { const int orow = crow(r, hi);
#pragma unroll
    for (int d0 = 0; d0 < 4; ++d0) *(bf16_t*)(Ol + orow * 256 + (d0 * 32 + r32) * 2) = f2bf(o[d0][r] * rli[r]); }
  asm volatile("s_waitcnt lgkmcnt(0)" ::: "memory");
#pragma unroll
  for (int e = 0; e < 8; ++e) { const int idx = lane + 64 * e, row = idx >> 4, ch = idx & 15;
    const u32x4 ov = *(const u32x4*)(Ol + row * 256 + ch * 16); const u32x4 z = zg[e];
    u32x4 y; y.x = cvt_pk_bf16(bflo(ov.x) * bflo(z.x), bfhi(ov.x) * bfhi(z.x)); y.y = cvt_pk_bf16(bflo(ov.y) * bflo(z.y), bfhi(ov.y) * bfhi(z.y));
    y.z = cvt_pk_bf16(bflo(ov.z) * bflo(z.z), bfhi(ov.z) * bfhi(z.z)); y.w = cvt_pk_bf16(bflo(ov.w) * bflo(z.w), bfhi(ov.w) * bfhi(z.w));
    *(u32x4*)(Yw + (long)row * DM + ch * 8) = y; }
  __syncthreads();
#undef ADMA
#undef AWAIT4
#undef AWAIT0
#undef KBUF
#undef VBUF
#undef RESC
}
}

namespace ml {
constexpr int ML_K0 = 0, ML_K1 = 16384, ML_V = 32768, ML_VW = 49152, ML_Q0 = 65536, ML_Q1 = 81920, ML_S = 98304, ML_N = 106496, ML_QN = 107520, ML_DP = 107776, ML_TAB = 108288;
__device__ __forceinline__ unsigned offb(unsigned row, unsigned ch) { return 256u * row + 16u * (ch ^ (((row & 3) << 2) | ((row >> 2) & 3))); }
template <int IMM> __device__ __forceinline__ s16x4 trr(unsigned addr) { s16x4 r; asm volatile("ds_read_b64_tr_b16 %0, %1 offset:%2" : "=&v"(r) : "v"(addr), "i"(IMM) : "memory"); return r; }
#define ML_PK(L, H) (bf16x8){L[0], L[1], L[2], L[3], H[0], H[1], H[2], H[3]}
__host__ __device__ constexpr unsigned trc(int c, int ks, int t) { return 8192u * ks + 1024u * t + 16u * ((((unsigned)c >> 1) << 2) | (((unsigned)c & 1) << 1) | (unsigned)t); }
__device__ __forceinline__ float scan_add(float v, int lane) {
    int l = lane; asm volatile("" : "+v"(l));
#pragma unroll
    for (int o = 1; o < 64; o <<= 1) { const float t = shfl_from(v, l - o); if (l >= o) v += t; }
    return v;
}
__device__ __forceinline__ float scan_max(float v, int lane) {
    int l = lane; asm volatile("" : "+v"(l));
#pragma unroll
    for (int o = 1; o < 64; o <<= 1) { const float t = shfl_from(v, l - o); if (l >= o) v = fmaxf(v, t); }
    return v;
}
struct KF { s16x4 a00, a01, a10, a11, b00, b01, b10, b11; };
template <int KIMG, int C0> __device__ __forceinline__ void kf_issue(KF& f, unsigned tb) {
    f.a00 = trr<KIMG>(tb ^ trc(C0, 0, 0)); f.a01 = trr<KIMG>(tb ^ trc(C0, 0, 1)); f.a10 = trr<KIMG>(tb ^ trc(C0, 1, 0)); f.a11 = trr<KIMG>(tb ^ trc(C0, 1, 1));
    f.b00 = trr<KIMG>(tb ^ trc(C0 + 1, 0, 0)); f.b01 = trr<KIMG>(tb ^ trc(C0 + 1, 0, 1)); f.b10 = trr<KIMG>(tb ^ trc(C0 + 1, 1, 0)); f.b11 = trr<KIMG>(tb ^ trc(C0 + 1, 1, 1));
}
__device__ __forceinline__ void kf_mma(f32x4& Ca, f32x4& Cb, const KF& f, const bf16x8 wb0, const bf16x8 wb1) {
    Ca = __builtin_amdgcn_mfma_f32_16x16x32_bf16(ML_PK(f.a00, f.a01), wb0, Ca, 0, 0, 0);
    Cb = __builtin_amdgcn_mfma_f32_16x16x32_bf16(ML_PK(f.b00, f.b01), wb0, Cb, 0, 0, 0);
    Ca = __builtin_amdgcn_mfma_f32_16x16x32_bf16(ML_PK(f.a10, f.a11), wb1, Ca, 0, 0, 0);
    Cb = __builtin_amdgcn_mfma_f32_16x16x32_bf16(ML_PK(f.b10, f.b11), wb1, Cb, 0, 0, 0);
}
#define ML_WAITL(n) asm volatile("s_waitcnt lgkmcnt(" #n ")" ::: "memory")
__device__ __forceinline__ void mlstm_item(LAS unsigned char* lds, const bf16_t* __restrict__ zin, const float* __restrict__ gsc, const float* __restrict__ chs, bf16_t* __restrict__ hout,
                                           int seqrow, int seqlen, int head, int dir, int dvh) {
    const int tid = opaque_tid();
    const int lane = tid & 63, w = __builtin_amdgcn_readfirstlane(tid >> 6), g = lane >> 4, l15 = lane & 15;
    const unsigned lb = (unsigned)(uintptr_t)lds;
    const int NC = seqlen / 64;
    LAS float* tab = (LAS float*)(lds + ML_TAB + w * 1280);
    LAS float* nst = (LAS float*)(lds + ML_N);
    LAS float* qn = (LAS float*)(lds + ML_QN);
    LAS float* dp = (LAS float*)(lds + ML_DP);
    const unsigned Fh = l15 & 3, Fl = (l15 >> 2) & 3, q4 = l15 >> 2, p4 = lane & 3;
    unsigned rrb = 256u * l15 + 64u * Fh + 16u * (g ^ Fl);
    unsigned qrb = 256u * l15 + 64u * Fh + 16u * ((g >> 1) ^ Fl) + 8u * (g & 1);
    unsigned trb = lb + 256u * (8u * g + q4) + 16u * ((q4 << 2) | ((g & 1) << 1) | (p4 >> 1)) + 8u * (p4 & 1);
    unsigned srb = 128u * l15 + 16u * (g ^ ((l15 >> 1) & 7));
    f32x4 C[16];
#pragma unroll
    for (int t = 0; t < 16; ++t) C[t] = (f32x4){0.f, 0.f, 0.f, 0.f};
    float m = 0.f, decay = 1.f;
    if (tid < 256) nst[tid] = 0.f;
    u32x4 sq[4], sk[4], sv[2]; f32x4 gs; f32x2 cs2;
    const bf16_t* zq = zin + (size_t)seqrow * NIN + C_MQ + head * 256;
    const bf16_t* zk = zin + (size_t)seqrow * NIN + C_MK + head * 256;
    const bf16_t* zv = zin + (size_t)seqrow * NIN + C_MV + head * 256 + dvh * 128;
    const float* gsb = gsc + ((size_t)dir * NTOK + seqrow) * 16 + head * 4;
    const float* chb = chs + ((size_t)dir * 512 + (seqrow >> 6)) * 8 + head * 2 + (tid >> 10);
#define ML_LOAD(c) do { const int cc_ = dir ? NC - 1 - (c) : (c); const int t0_ = cc_ * 64;                                    \
        _Pragma("unroll") for (int e = 0; e < 4; ++e) { const int idx = tid + 512 * e, row = idx >> 5, ch = idx & 31; const int tok = dir ? t0_ + 63 - row : t0_ + row; \
            sq[e] = *(const u32x4*)(zq + (size_t)tok * NIN + ch * 8); sk[e] = *(const u32x4*)(zk + (size_t)tok * NIN + ch * 8); }      \
        _Pragma("unroll") for (int e = 0; e < 2; ++e) { const int idx = tid + 512 * e, row = idx >> 4, ch = idx & 15; const int tok = dir ? t0_ + 63 - row : t0_ + row; \
            sv[e] = *(const u32x4*)(zv + (size_t)tok * NIN + ch * 8); }                                                      \
        { const int tok = dir ? t0_ + 63 - lane : t0_ + lane; gs = *(const f32x4*)(gsb + (size_t)tok * 16); cs2 = *(const f32x2*)(chb + (size_t)cc_ * 8); } } while (0)
#define ML_SCALARS() do { const float A_ = fmaxf(m, gs[1]); const float A63_ = fmaxf(m, cs2[1]);                               \
        tab[lane] = gs[0]; tab[64 + lane] = A_; tab[128 + lane] = fast_exp(m - A_); tab[192 + lane] = fast_exp(-(gs[2] + A_)); tab[256 + lane] = fast_exp(gs[0] - A63_); \
        decay = fast_exp(m - A63_); m = cs2[0] + A63_; LDS_WAIT(); } while (0)
#define ML_STAGE() do {                                                                                                     \
        _Pragma("unroll") for (int e = 0; e < 4; ++e) { const int idx = tid + 512 * e, row = idx >> 5, ch = idx & 31;          \
            *(LAS u32x4*)(lds + ((ch >> 4) ? ML_Q1 : ML_Q0) + offb(row, ch & 15)) = sq[e]; *(LAS u32x4*)(lds + ((ch >> 4) ? ML_K1 : ML_K0) + offb(row, ch & 15)) = sk[e]; } \
        _Pragma("unroll") for (int e = 0; e < 2; ++e) { const int idx = tid + 512 * e, row = idx >> 4, ch = idx & 15; const float wk_ = tab[256 + row]; \
            *(LAS u32x4*)(lds + ML_V + offb(row, ch)) = sv[e]; u32x4 x = sv[e], y;                                             \
            y.x = cvt_pk_bf16(bflo(x.x) * wk_, bfhi(x.x) * wk_); y.y = cvt_pk_bf16(bflo(x.y) * wk_, bfhi(x.y) * wk_);          \
            y.z = cvt_pk_bf16(bflo(x.z) * wk_, bfhi(x.z) * wk_); y.w = cvt_pk_bf16(bflo(x.w) * wk_, bfhi(x.w) * wk_);          \
            *(LAS u32x4*)(lds + ML_VW + offb(row, ch)) = y; } } while (0)
    ML_LOAD(0);
    ML_SCALARS();
    ML_STAGE();
    __syncthreads();
    for (int c = 0; c < NC; ++c) {
        const int cc = dir ? NC - 1 - c : c, t0 = cc * 64;
        const float decay_c = decay;
        asm volatile("" : "+v"(rrb), "+v"(qrb), "+v"(trb), "+v"(srb));
        int opq_ = tid; asm volatile("" : "+v"(opq_));
        const int tid = opq_, lane = tid & 63, g = lane >> 4, l15 = lane & 15;
        {
            const int it = w >> 1, jt0 = (w & 1) * 2;
            f32x4 s0 = (f32x4){0.f, 0.f, 0.f, 0.f}, s1 = s0;
            bf16x8 kf0[4], kf1[4], qf[4];
#define ML_S1LOAD(s, b) do { const int qo = ((s) >> 2) ? ML_Q1 : ML_Q0, ko = ((s) >> 2) ? ML_K1 : ML_K0; const unsigned ra = rrb ^ (64u * ((s) & 3));   \
                kf0[b] = *(const LAS bf16x8*)(lds + ko + 4096 * jt0 + ra); kf1[b] = *(const LAS bf16x8*)(lds + ko + 4096 * jt0 + 4096 + ra); qf[b] = *(const LAS bf16x8*)(lds + qo + 4096 * it + ra); } while (0)
            ML_S1LOAD(0, 0); ML_S1LOAD(1, 1); ML_S1LOAD(2, 2);
#pragma unroll
            for (int s = 0; s < 8; ++s) {
                if (s < 5) ML_S1LOAD(s + 3, (s + 3) & 3);
                s0 = __builtin_amdgcn_mfma_f32_16x16x32_bf16(kf0[s & 3], qf[s & 3], s0, 0, 0, 0);
                s1 = __builtin_amdgcn_mfma_f32_16x16x32_bf16(kf1[s & 3], qf[s & 3], s1, 0, 0, 0);
            }
#undef ML_S1LOAD
            const int il = 16 * it + l15;
            const float Ai = tab[64 + il];
            float ps = 0.f;
#pragma unroll
            for (int tt = 0; tt < 2; ++tt) {
                const int jt = jt0 + tt, j0 = 16 * jt + 4 * g;
                const f32x4 av = *(const LAS f32x4*)(tab + j0);
                const f32x4 sx = tt ? s1 : s0;
                float sw[4];
#pragma unroll
                for (int r = 0; r < 4; ++r) { const float wgt = (j0 + r <= il) ? fast_exp(av[r] - Ai) : 0.f; sw[r] = sx[r] * wgt; ps += sw[r]; }
                u32x2 pk; pk.x = cvt_pk_bf16(sw[0], sw[1]); pk.y = cvt_pk_bf16(sw[2], sw[3]);
                *(LAS u32x2*)(lds + ML_S + il * 128 + (((2 * jt + (g >> 1)) ^ ((il >> 1) & 7)) << 4) + (g & 1) * 8) = pk;
            }
            ps = addx<16>(ps); ps = addx<32>(ps);
            if (g == 0) dp[il * 2 + (w & 1)] = ps;
        }
        {
            const int i = tid >> 3, sl = tid & 7;
            const unsigned qb0 = offb(i, 4 * (sl & 3));
            float a = 0.f;
#pragma unroll
            for (int cch = 0; cch < 4; ++cch) {
                const u32x4 x = *(const LAS u32x4*)(lds + ((sl >> 2) ? ML_Q1 : ML_Q0) + (qb0 ^ (16u * cch)));
                const f32x4 n0 = *(const LAS f32x4*)(nst + 32 * sl + 8 * cch), n1 = *(const LAS f32x4*)(nst + 32 * sl + 8 * cch + 4);
                a += bflo(x.x) * n0[0] + bfhi(x.x) * n0[1] + bflo(x.y) * n0[2] + bfhi(x.y) * n0[3] + bflo(x.z) * n1[0] + bfhi(x.z) * n1[1] + bflo(x.w) * n1[2] + bfhi(x.w) * n1[3];
            }
            a = addx<1>(a); a = addx<2>(a); a = addx<4>(a);
            if (sl == 0) qn[i] = a;
        }
        __syncthreads();
        const unsigned tbw = trb ^ trc(w, 0, 0);
        {
            f32x4 a1[4], a2[4];
#pragma unroll
            for (int t = 0; t < 4; ++t) { a1[t] = (f32x4){0.f, 0.f, 0.f, 0.f}; a2[t] = a1[t]; }
            {
                const s16x4 v00 = trr<ML_V>(tbw ^ trc(0, 0, 0)), v01 = trr<ML_V>(tbw ^ trc(0, 0, 1)), v10 = trr<ML_V>(tbw ^ trc(0, 1, 0)), v11 = trr<ML_V>(tbw ^ trc(0, 1, 1));
                bf16x8 sa[2][4];
#pragma unroll
                for (int ks = 0; ks < 2; ++ks)
#pragma unroll
                    for (int t = 0; t < 4; ++t) sa[ks][t] = *(const LAS bf16x8*)(lds + ML_S + 2048 * t + (srb ^ (64u * ks)));
                LDS_WAIT(); SBAR();
                const bf16x8 vb0 = ML_PK(v00, v01), vb1 = ML_PK(v10, v11);
#pragma unroll
                for (int t = 0; t < 4; ++t) { a1[t] = __builtin_amdgcn_mfma_f32_16x16x32_bf16(sa[0][t], vb0, a1[t], 0, 0, 0); a1[t] = __builtin_amdgcn_mfma_f32_16x16x32_bf16(sa[1][t], vb1, a1[t], 0, 0, 0); }
                SBAR();
            }
            u32x2 qf[2][8];
#define ML_QLOAD(s, b) do { const int qo = ((s) >> 2) ? ML_Q1 : ML_Q0; const unsigned qa1 = qrb ^ (64u * ((s) & 3)), qa2 = qrb ^ (64u * ((s) & 3) + 32u);   \
                _Pragma("unroll") for (int t = 0; t < 4; ++t) { qf[b][2 * t] = *(const LAS u32x2*)(lds + qo + 4096 * t + qa1); qf[b][2 * t + 1] = *(const LAS u32x2*)(lds + qo + 4096 * t + qa2); } } while (0)
            ML_QLOAD(0, 0);
#pragma unroll
            for (int s = 0; s < 8; ++s) {
                if (s < 7) ML_QLOAD(s + 1, (s + 1) & 1);
                u32x4 cbw; cbw.x = cvt_pk_bf16(C[2 * s][0], C[2 * s][1]); cbw.y = cvt_pk_bf16(C[2 * s][2], C[2 * s][3]);
                cbw.z = cvt_pk_bf16(C[2 * s + 1][0], C[2 * s + 1][1]); cbw.w = cvt_pk_bf16(C[2 * s + 1][2], C[2 * s + 1][3]);
                const bf16x8 cb = *reinterpret_cast<const bf16x8*>(&cbw);
#pragma unroll
                for (int t = 0; t < 4; ++t) {
                    u32x4 qw; qw.x = qf[s & 1][2 * t].x; qw.y = qf[s & 1][2 * t].y; qw.z = qf[s & 1][2 * t + 1].x; qw.w = qf[s & 1][2 * t + 1].y;
                    a2[t] = __builtin_amdgcn_mfma_f32_16x16x32_bf16(*reinterpret_cast<const bf16x8*>(&qw), cb, a2[t], 0, 0, 0);
                }
                SBAR();
            }
#undef ML_QLOAD
            bf16_t* hp = hout + (size_t)seqrow * 1024 + head * 256 + dvh * 128 + 16 * w + l15;
#pragma unroll
            for (int t = 0; t < 4; ++t) {
                const int i0 = 16 * t + 4 * g;
                const f32x4 wi4 = *(const LAS f32x4*)(tab + 128 + i0), em4 = *(const LAS f32x4*)(tab + 192 + i0), qn4 = *(const LAS f32x4*)(qn + i0);
                const f32x4 d0 = *(const LAS f32x4*)(dp + 2 * i0), d1 = *(const LAS f32x4*)(dp + 2 * i0 + 4);
                const float dsum[4] = {d0[0] + d0[1], d0[2] + d0[3], d1[0] + d1[1], d1[2] + d1[3]};
#pragma unroll
                for (int r = 0; r < 4; ++r) {
                    const float den = dsum[r] + wi4[r] * qn4[r];
                    const float num = a1[t][r] + wi4[r] * a2[t][r];
                    const float hv = num * __builtin_amdgcn_rcpf(fmaxf(fabsf(den), em4[r]));
                    const int i = i0 + r; const int tok = dir ? t0 + 63 - i : t0 + i;
                    hp[(size_t)tok * 1024] = f2bf(hv);
                }
            }
        }
        SBAR();
        if (c + 1 < NC) ML_LOAD(c + 1);
        {
            {
                const unsigned tn = (trb + ((w >> 2) ? 16384u : 0u)) ^ (64u * (unsigned)(w & 3));
                KF fn; kf_issue<0, 0>(fn, tn);
                const f32x4 k0a = *(const LAS f32x4*)(tab + 256 + 8 * g), k0b = *(const LAS f32x4*)(tab + 260 + 8 * g), k1a = *(const LAS f32x4*)(tab + 288 + 8 * g), k1b = *(const LAS f32x4*)(tab + 292 + 8 * g);
                u32x4 nw0, nw1, nx0, nx1;
                nw0.x = cvt_pk_bf16(k0a[0], k0a[1]); nw0.y = cvt_pk_bf16(k0a[2], k0a[3]); nw0.z = cvt_pk_bf16(k0b[0], k0b[1]); nw0.w = cvt_pk_bf16(k0b[2], k0b[3]);
                nw1.x = cvt_pk_bf16(k1a[0], k1a[1]); nw1.y = cvt_pk_bf16(k1a[2], k1a[3]); nw1.z = cvt_pk_bf16(k1b[0], k1b[1]); nw1.w = cvt_pk_bf16(k1b[2], k1b[3]);
                nx0.x = cvt_pk_bf16(k0a[0] - bflo(nw0.x), k0a[1] - bfhi(nw0.x)); nx0.y = cvt_pk_bf16(k0a[2] - bflo(nw0.y), k0a[3] - bfhi(nw0.y)); nx0.z = cvt_pk_bf16(k0b[0] - bflo(nw0.z), k0b[1] - bfhi(nw0.z)); nx0.w = cvt_pk_bf16(k0b[2] - bflo(nw0.w), k0b[3] - bfhi(nw0.w));
                nx1.x = cvt_pk_bf16(k1a[0] - bflo(nw1.x), k1a[1] - bfhi(nw1.x)); nx1.y = cvt_pk_bf16(k1a[2] - bflo(nw1.y), k1a[3] - bfhi(nw1.y)); nx1.z = cvt_pk_bf16(k1b[0] - bflo(nw1.z), k1b[1] - bfhi(nw1.z)); nx1.w = cvt_pk_bf16(k1b[2] - bflo(nw1.w), k1b[3] - bfhi(nw1.w));
                if (l15 != 0) { nw0 = (u32x4){0u, 0u, 0u, 0u}; nw1 = nw0; nx0 = nw0; nx1 = nw0; }
                const bf16x8 nb0 = *reinterpret_cast<const bf16x8*>(&nw0), nb1 = *reinterpret_cast<const bf16x8*>(&nw1), nl0 = *reinterpret_cast<const bf16x8*>(&nx0), nl1 = *reinterpret_cast<const bf16x8*>(&nx1);
                LAS f32x4* pa = (LAS f32x4*)(nst + 32 * w + 4 * g); LAS f32x4* pb = (LAS f32x4*)(nst + 32 * w + 16 + 4 * g);
                f32x4 na = *pa * decay_c, nb = *pb * decay_c;
                LDS_WAIT(); SBAR();
                const bf16x8 A0 = ML_PK(fn.a00, fn.a01), A1 = ML_PK(fn.a10, fn.a11), B0 = ML_PK(fn.b00, fn.b01), B1 = ML_PK(fn.b10, fn.b11);
                na = __builtin_amdgcn_mfma_f32_16x16x32_bf16(A0, nb0, na, 0, 0, 0); nb = __builtin_amdgcn_mfma_f32_16x16x32_bf16(B0, nb0, nb, 0, 0, 0);
                na = __builtin_amdgcn_mfma_f32_16x16x32_bf16(A1, nb1, na, 0, 0, 0); nb = __builtin_amdgcn_mfma_f32_16x16x32_bf16(B1, nb1, nb, 0, 0, 0);
                na = __builtin_amdgcn_mfma_f32_16x16x32_bf16(A0, nl0, na, 0, 0, 0); nb = __builtin_amdgcn_mfma_f32_16x16x32_bf16(B0, nl0, nb, 0, 0, 0);
                na = __builtin_amdgcn_mfma_f32_16x16x32_bf16(A1, nl1, na, 0, 0, 0); nb = __builtin_amdgcn_mfma_f32_16x16x32_bf16(B1, nl1, nb, 0, 0, 0);
                if (l15 == 0) { *pa = na; *pb = nb; }
                SBAR();
            }
            const s16x4 w00 = trr<ML_VW>(tbw ^ trc(0, 0, 0)), w01 = trr<ML_VW>(tbw ^ trc(0, 0, 1)), w10 = trr<ML_VW>(tbw ^ trc(0, 1, 0)), w11 = trr<ML_VW>(tbw ^ trc(0, 1, 1));
            KF f0, f1;
            kf_issue<ML_K0, 0>(f0, trb);
#pragma unroll
            for (int t = 0; t < 16; ++t) C[t] = C[t] * decay_c;
            LDS_WAIT(); SBAR();
            const bf16x8 wb0 = ML_PK(w00, w01), wb1 = ML_PK(w10, w11);
            kf_issue<ML_K0, 2>(f1, trb); ML_WAITL(8); SBAR(); kf_mma(C[0], C[1], f0, wb0, wb1); SBAR();
            kf_issue<ML_K0, 4>(f0, trb); ML_WAITL(8); SBAR(); kf_mma(C[2], C[3], f1, wb0, wb1); SBAR();
            kf_issue<ML_K0, 6>(f1, trb); ML_WAITL(8); SBAR(); kf_mma(C[4], C[5], f0, wb0, wb1); SBAR();
            kf_issue<ML_K1, 0>(f0, trb); ML_WAITL(8); SBAR(); kf_mma(C[6], C[7], f1, wb0, wb1); SBAR();
            kf_issue<ML_K1, 2>(f1, trb); ML_WAITL(8); SBAR(); kf_mma(C[8], C[9], f0, wb0, wb1); SBAR();
            kf_issue<ML_K1, 4>(f0, trb); ML_WAITL(8); SBAR(); kf_mma(C[10], C[11], f1, wb0, wb1); SBAR();
            kf_issue<ML_K1, 6>(f1, trb); ML_WAITL(8); SBAR(); kf_mma(C[12], C[13], f0, wb0, wb1); SBAR();
            ML_WAITL(0); SBAR(); kf_mma(C[14], C[15], f1, wb0, wb1); SBAR();
        }
        __syncthreads();
        if (c + 1 < NC) { ML_SCALARS(); ML_STAGE(); }
        __syncthreads();
    }
#undef ML_LOAD
#undef ML_SCALARS
#undef ML_STAGE
}
}

struct Args {
    const float* x_prompt; const float* x_sample; const float* p_prompt; const float* p_sample;
    const float* norm_pre; const float* w_in; const float* b_gate; const float* w_pool; const float* pool_scale;
    const float* mlstm_norm; const float* q_norm; const float* k_norm; const float* w_out; const float* norm_post;
    const float* w_ple_proj; const float* w_ple_gate; const float* ple_norm;
    float* out; unsigned char* ws; int ph_lo, ph_hi;
};

typedef const Args __attribute__((address_space(4)))* KArgsP;
__device__ __forceinline__ Args load_args(KArgsP p) {
    Args a; a.x_prompt = p->x_prompt; a.x_sample = p->x_sample; a.p_prompt = p->p_prompt; a.p_sample = p->p_sample; a.norm_pre = p->norm_pre; a.w_in = p->w_in; a.b_gate = p->b_gate; a.w_pool = p->w_pool;
    a.pool_scale = p->pool_scale; a.mlstm_norm = p->mlstm_norm; a.q_norm = p->q_norm; a.k_norm = p->k_norm; a.w_out = p->w_out; a.norm_post = p->norm_post; a.w_ple_proj = p->w_ple_proj; a.w_ple_gate = p->w_ple_gate;
    a.ple_norm = p->ple_norm; a.out = p->out; a.ws = p->ws; a.ph_lo = p->ph_lo; a.ph_hi = p->ph_hi; return a;
}
__device__ const double ROPE_INV[32] = {
    1.0, 0.7498942093324559, 0.5623413251903491, 0.4216965034285822, 0.31622776601683794, 0.23713737056616552, 0.1778279410038923, 0.1333521432163324,
    0.1, 0.07498942093324558, 0.05623413251903491, 0.04216965034285822, 0.03162277660168379, 0.023713737056616554, 0.01778279410038923, 0.01333521432163324,
    0.01, 0.007498942093324558, 0.005623413251903491, 0.004216965034285823, 0.0031622776601683794, 0.0023713737056616554, 0.0017782794100389228, 0.001333521432163324,
    0.001, 0.0007498942093324559, 0.0005623413251903491, 0.0004216965034285823, 0.00031622776601683794, 0.00023713737056616554, 0.00017782794100389227, 0.0001333521432163324};

__device__ __forceinline__ void transpose_item(const float* __restrict__ W, int ldw, int srcc0, int K, bf16_t* __restrict__ WT, int n0, int k0, LAS float* scr, int lane) {
    { const int kr = lane >> 3, c4 = lane & 7;
      f32x4 x[8];
#pragma unroll
      for (int i = 0; i < 8; ++i) x[i] = *(const f32x4*)(W + (size_t)(k0 + 8 * i + kr) * ldw + srcc0 + 4 * c4);
#pragma unroll
      for (int i = 0; i < 8; ++i) { LAS float* d = scr + (8 * i + kr) * 33 + 4 * c4; d[0] = x[i][0]; d[1] = x[i][1]; d[2] = x[i][2]; d[3] = x[i][3]; } }
    LDS_WAIT(); asm volatile("" ::: "memory");
    const int c = lane & 7;
#pragma unroll
    for (int j = 0; j < 4; ++j) { const int n = (lane >> 3) + 8 * j; const LAS float* s = scr + (8 * c) * 33 + n;
        u32x4 o; o.x = cvt_pk_bf16(s[0 * 33], s[1 * 33]); o.y = cvt_pk_bf16(s[2 * 33], s[3 * 33]); o.z = cvt_pk_bf16(s[4 * 33], s[5 * 33]); o.w = cvt_pk_bf16(s[6 * 33], s[7 * 33]);
        *(u32x4*)(WT + (size_t)(n0 + n) * K + k0 + 8 * c) = o; }
    LDS_WAIT(); asm volatile("" ::: "memory");
}

__device__ __forceinline__ void convert_layer_weights(const Args& a, int l, int gw, int ngw, LAS float* scr, int lane) {
    unsigned char* ws = a.ws;
    bf16_t* WIN = (bf16_t*)(ws + WS_WIN); bf16_t* WOUT = (bf16_t*)(ws + WS_WOUT); bf16_t* WGATE = (bf16_t*)(ws + WS_WGATE); bf16_t* WPROJ = (bf16_t*)(ws + WS_WPROJ); bf16_t* WPOOL = (bf16_t*)(ws + WS_WPOOL);
    constexpr int I_IN = 64 * 384, I_SQ = 64 * 128, I_PJ = 4 * 128, I_PL = 4 * 8;
    constexpr int NIT = I_IN + 2 * I_SQ + I_PJ + 4 * I_PL;
    for (int it = gw; it < NIT; it += ngw) {
        int r = it;
        if (r < I_IN) { const int kb = r / 384, nb = r % 384, n0 = nb * 32; transpose_item(a.w_in + (size_t)l * DM * NINSRC, NINSRC, n0 + (n0 >= 7168 ? 16 : 0), DM, WIN, n0, kb * 64, scr, lane); continue; } r -= I_IN;
        if (r < I_SQ) { const int kb = r / 128, nb = r % 128; transpose_item(a.w_out + (size_t)l * DM * DM, DM, nb * 32, DM, WOUT, nb * 32, kb * 64, scr, lane); continue; } r -= I_SQ;
        if (r < I_SQ) { const int kb = r / 128, nb = r % 128; transpose_item(a.w_ple_gate + (size_t)l * DM * DM, DM, nb * 32, DM, WGATE, nb * 32, kb * 64, scr, lane); continue; } r -= I_SQ;
        if (r < I_PJ) { const int kb = r / 128, nb = r % 128; transpose_item(a.w_ple_proj + (size_t)l * PLE * DM, DM, nb * 32, PLE, WPROJ, nb * 32, kb * 64, scr, lane); continue; } r -= I_PJ;
        { const int gq = r / I_PL, rr = r % I_PL, kb = rr / 8, nb = rr % 8; transpose_item(a.w_pool + (size_t)(l * 4 + gq) * 65536, 256, nb * 32, 256, WPOOL + (size_t)gq * 65536, nb * 32, kb * 64, scr, lane); }
    }
}

__device__ __forceinline__ const float* xrow_ptr(const Args& a, int row) { return row < NPROMPT ? a.x_prompt + (size_t)row * DM : a.x_sample + (size_t)(row - NPROMPT) * DM; }

template <int SRC>
__device__ __forceinline__ void norm_gates_phase(const Args& a, int lnext, int lprev, int gw, int ngw, int lane) {
    unsigned char* ws = a.ws;
    bf16_t* H = (bf16_t*)(ws + WS_H); const bf16_t* PL = (const bf16_t*)(ws + WS_Y); const float* stats = (const float*)(ws + WS_STATS);
    float* gates = (float*)(ws + WS_GATES);
    for (int grp = gw; grp < NTOK / 16; grp += ngw) {
        for (int rr = 0; rr < 16; ++rr) {
            const int row = grp * 16 + rr;
            f32x4 v[8][2];
            if (SRC == 0) {
                const f32x4* xr = (const f32x4*)xrow_ptr(a, row) + 2 * lane;
#pragma unroll
                for (int j = 0; j < 8; ++j) { v[j][0] = __builtin_nontemporal_load(xr + 128 * j); v[j][1] = __builtin_nontemporal_load(xr + 128 * j + 1); }
            } else {
                const float st = stats[(size_t)row * 64 + lane];
                const float rstd = __builtin_amdgcn_rsqf(wave_sum(st) * (1.f / DM) + EPS);
                f32x4* xr = (f32x4*)(a.out + (size_t)row * DM) + 2 * lane;
                u32x4* xbr = (u32x4*)((bf16_t*)a.out + (size_t)row * DM) + lane;
                const u32x4* x1r = (const u32x4*)(H + (size_t)row * DM) + lane;
                const u32x4* pr = (const u32x4*)(PL + (size_t)row * DM) + lane;
                const f32x4* gr = (const f32x4*)(a.ple_norm + (size_t)lprev * DM) + 2 * lane;
                u32x4 xq[8], pq[8];
#pragma unroll
                for (int j = 0; j < 8; ++j) { xq[j] = __builtin_nontemporal_load(x1r + 64 * j); pq[j] = __builtin_nontemporal_load(pr + 64 * j); }
#pragma unroll
                for (int j = 0; j < 8; ++j) { const u32x4 x = xq[j], p = pq[j]; const f32x4 g0 = gr[128 * j], g1 = gr[128 * j + 1];
                    f32x4 y0, y1;
                    y0[0] = bflo(x.x) + bflo(p.x) * rstd * g0[0]; y0[1] = bfhi(x.x) + bfhi(p.x) * rstd * g0[1]; y0[2] = bflo(x.y) + bflo(p.y) * rstd * g0[2]; y0[3] = bfhi(x.y) + bfhi(p.y) * rstd * g0[3];
                    y1[0] = bflo(x.z) + bflo(p.z) * rstd * g1[0]; y1[1] = bfhi(x.z) + bfhi(p.z) * rstd * g1[1]; y1[2] = bflo(x.w) + bflo(p.w) * rstd * g1[2]; y1[3] = bfhi(x.w) + bfhi(p.w) * rstd * g1[3];
                    v[j][0] = y0; v[j][1] = y1;
                    if (lnext < DEPTH) { u32x4 o; o.x = cvt_pk_bf16(y0[0], y0[1]); o.y = cvt_pk_bf16(y0[2], y0[3]); o.z = cvt_pk_bf16(y1[0], y1[1]); o.w = cvt_pk_bf16(y1[2], y1[3]); xbr[64 * j] = o; }
                    else { xr[128 * j] = y0; xr[128 * j + 1] = y1; } }
            }
            if (lnext < DEPTH) {
                float ss = 0.f;
#pragma unroll
                for (int j = 0; j < 8; ++j)
#pragma unroll
                    for (int h2 = 0; h2 < 2; ++h2) ss += (v[j][h2][0] * v[j][h2][0] + v[j][h2][1] * v[j][h2][1]) + (v[j][h2][2] * v[j][h2][2] + v[j][h2][3] * v[j][h2][3]);
                const float r = __builtin_amdgcn_rsqf(wave_sum(ss) * (1.f / DM) + EPS);
                const f32x4* gr = (const f32x4*)(a.norm_pre + (size_t)lnext * DM) + 2 * lane;
                u32x4* o8 = (u32x4*)(H + (size_t)row * DM) + lane;
#pragma unroll
                for (int j = 0; j < 8; ++j) { const f32x4 g0 = gr[128 * j], g1 = gr[128 * j + 1]; u32x4 o;
                    o.x = cvt_pk_bf16(v[j][0][0] * r * g0[0], v[j][0][1] * r * g0[1]); o.y = cvt_pk_bf16(v[j][0][2] * r * g0[2], v[j][0][3] * r * g0[3]);
                    o.z = cvt_pk_bf16(v[j][1][0] * r * g1[0], v[j][1][1] * r * g1[1]); o.w = cvt_pk_bf16(v[j][1][2] * r * g1[2], v[j][1][3] * r * g1[3]); o8[64 * j] = o; }
            }
        }
        if (lnext < DEPTH) {
            VM_WAIT();
            const bf16_t* Hg = H + (size_t)(grp * 16 + (lane & 15)) * DM + 8 * (lane >> 4);
            const bf16_t* Wg = (const bf16_t*)(ws + WS_WG) + (size_t)lnext * 16 * DM + (size_t)(lane & 15) * DM + 8 * (lane >> 4);
            f32x4 acc = (f32x4){0.f, 0.f, 0.f, 0.f};
#pragma unroll 8
            for (int ks = 0; ks < DM / 32; ++ks) {
                const bf16x8 af = *(const bf16x8*)(Hg + ks * 32), bf = *(const bf16x8*)(Wg + ks * 32);
                acc = __builtin_amdgcn_mfma_f32_16x16x32_bf16(af, bf, acc, 0, 0, 0);
            }
            const int col = lane & 15; const float bias = a.b_gate[lnext * 16 + col]; const bool isf = (col & 4) != 0;
#pragma unroll
            for (int r = 0; r < 4; ++r) { float gv = acc[r] + bias;
                if (isf) { const float e = fast_exp(-fabsf(gv)); gv = fminf(gv, 0.f) - __logf(1.f + e); }
                gates[(size_t)(grp * 16 + 4 * (lane >> 4) + r) * 16 + col] = gv; }
        }
    }
}

constexpr int NCOMB = 128;
constexpr int PH_PRO = 0, PH_NORM0 = 1, PH_L0 = 2, PH_PER_LAYER = 8, N_PHASES = PH_L0 + DEPTH * PH_PER_LAYER;

#define PHASE_IDS() const int tid = opaque_tid(), lane = tid & 63, wave = __builtin_amdgcn_readfirstlane(tid >> 6), gw = bx * NWAVES + wave, gt = bx * (NWAVES * 64) + tid; (void)lane; (void)gw; (void)gt
#if MK_ONE_LAUNCH
#define GRID_BAR() xcd_barrier(bar)
#else
#define GRID_BAR() do {} while (0)
#endif
#ifdef ONLY_SUB
#define IN(k) (((k) < PH_L0 ? 100 + (k) : ((k) - PH_L0) % PH_PER_LAYER) == ONLY_SUB && lo <= (k) && (k) < hi)
#else
#define IN(k) (lo <= (k) && (k) < hi)
#endif
#define SEAM(k) do { if (IN(k) && IN((k) + 1)) GRID_BAR(); } while (0)
#define PHASE_PTRS() KArgsP ap_ = (KArgsP)__builtin_amdgcn_kernarg_segment_ptr(); asm volatile("" : "+s"(ap_)); \
    const Args a = load_args(ap_); unsigned char* ws = a.ws; (void)ws; \
    bf16_t* WIN = (bf16_t*)(ws + WS_WIN); bf16_t* WOUT = (bf16_t*)(ws + WS_WOUT); bf16_t* WGATE = (bf16_t*)(ws + WS_WGATE); bf16_t* WPROJ = (bf16_t*)(ws + WS_WPROJ); bf16_t* WPOOL = (bf16_t*)(ws + WS_WPOOL); bf16_t* WG = (bf16_t*)(ws + WS_WG); \
    bf16_t* PB = (bf16_t*)(ws + WS_PB); bf16_t* H = (bf16_t*)(ws + WS_H); bf16_t* ZIN = (bf16_t*)(ws + WS_ZIN); bf16_t* DPOOL = (bf16_t*)(ws + WS_DPOOL); \
    bf16_t* HF = (bf16_t*)(ws + WS_HF); bf16_t* HB = (bf16_t*)(ws + WS_HB); bf16_t* Y = (bf16_t*)(ws + WS_Y); bf16_t* YO = (bf16_t*)(ws + WS_YO); bf16_t* PP = (bf16_t*)(ws + WS_PP); \
    float* STATS = (float*)(ws + WS_STATS); float* GATES = (float*)(ws + WS_GATES); f32x2* ROPE = (f32x2*)(ws + WS_ROPE); float* GSC = (float*)(ws + WS_GSC); float* CHS = (float*)(ws + WS_CHS); unsigned* ctl = (unsigned*)(ws + WS_CTL); bf16_t* KC = (bf16_t*)(ws + WS_KC); bf16_t* VC = (bf16_t*)(ws + WS_VC); (void)KC; (void)VC; \
    (void)WIN; (void)WOUT; (void)WGATE; (void)WPROJ; (void)WPOOL; (void)WG; (void)PB; (void)H; (void)ZIN; (void)DPOOL; (void)HF; (void)HB; (void)Y; (void)YO; (void)PP; (void)STATS; (void)GATES; (void)ROPE; (void)GSC; (void)CHS; (void)ctl

template <int l>
__device__ __forceinline__ void layer_body(LAS unsigned char* lds, unsigned char* lds_raw, volatile LAS unsigned* MISC, const XcdBarrier& bar, int G, int bx, int vcu, int ngw, int ngt, int lo, int hi) {
        const int pb = PH_L0 + l * PH_PER_LAYER;
        if (IN(pb + 0)) for (int rep_ = 0; rep_ < PROBE_INPROJ; ++rep_) {
            PHASE_PTRS();
            pg8::Gemm g{H, WIN, NTOK, NIN, DM, DM, DM, 0}; pg8::StaticOrder S; S.init(NTOK, NIN, G, bx);
            Epi<0> E{ZIN, NIN, nullptr, nullptr, 0, nullptr};
            pg8::gemm_phase<Epi<0>>(lds, g, S, E);
        }
        SEAM(pb + 0);
        if (IN(pb + 1)) {
            PHASE_PTRS(); PHASE_IDS();
            {
                const int hq = lane >> 4, e0 = 8 * (lane & 15);
                const int halfid = e0 >> 6, eh = e0 & 63; const bool isb = eh >= 32; const int f0 = eh & 31;
                float gq[8], gk[8];
                { const float* gn = a.q_norm + l * 128 + e0; const f32x4 g0 = *(const f32x4*)gn, g1 = *(const f32x4*)(gn + 4); gq[0] = g0[0]; gq[1] = g0[1]; gq[2] = g0[2]; gq[3] = g0[3]; gq[4] = g1[0]; gq[5] = g1[1]; gq[6] = g1[2]; gq[7] = g1[3];
#pragma unroll
                  for (int j = 0; j < 8; ++j) gq[j] *= att::SCALE * 1.4426950408889634f; }
                { const float* gn = a.k_norm + l * 128 + e0; const f32x4 g0 = *(const f32x4*)gn, g1 = *(const f32x4*)(gn + 4); gk[0] = g0[0]; gk[1] = g0[1]; gk[2] = g0[2]; gk[3] = g0[3]; gk[4] = g1[0]; gk[5] = g1[1]; gk[6] = g1[2]; gk[7] = g1[3]; }
                for (int row = gw; row < NTOK; row += ngw) {
                    const int pos = row < NPROMPT ? (row & 8191) : (row & 4095);
                    bf16_t* zr = ZIN + (size_t)row * NIN;
                    u32x4 xin[5];
#pragma unroll
                    for (int q = 0; q < 5; ++q) xin[q] = *(const u32x4*)(zr + (q < 4 ? C_AQ + (q * 4 + hq) * 128 : C_AK + hq * 128) + e0);
                    const int rp = halfid ? (pos & 63) : (pos >> 6);
                    const f32x4* cs4 = (const f32x4*)(ROPE + rp * 32 + f0);
                    const f32x4 c01 = cs4[0], c23 = cs4[1], c45 = cs4[2], c67 = cs4[3];
                    const float cc[8] = {c01[0], c01[2], c23[0], c23[2], c45[0], c45[2], c67[0], c67[2]}, sn[8] = {c01[1], c01[3], c23[1], c23[3], c45[1], c45[3], c67[1], c67[3]};
#pragma unroll
                    for (int q = 0; q < 5; ++q) {
                        const u32x4 x = xin[q];
                        float v[8] = {bflo(x.x), bfhi(x.x), bflo(x.y), bfhi(x.y), bflo(x.z), bfhi(x.z), bflo(x.w), bfhi(x.w)};
                        float ss = 0.f;
#pragma unroll
                        for (int j = 0; j < 8; ++j) ss += v[j] * v[j];
                        ss = addx<1>(ss); ss = addx<2>(ss); ss = addx<4>(ss); ss = addx<8>(ss);
                        const float r = __builtin_amdgcn_rsqf(ss * (1.f / 128.f) + EPS);
                        float o[8];
#pragma unroll
                        for (int j = 0; j < 8; ++j) { const float xn = v[j] * r * (q < 4 ? gq[j] : gk[j]); const float pj = swz_xor<4>(xn); o[j] = isb ? xn * cc[j] + pj * sn[j] : xn * cc[j] - pj * sn[j]; }
                        u32x4 w; w.x = cvt_pk_bf16(o[0], o[1]); w.y = cvt_pk_bf16(o[2], o[3]); w.z = cvt_pk_bf16(o[4], o[5]); w.w = cvt_pk_bf16(o[6], o[7]);
                        if (q < 4) *(u32x4*)(zr + C_AQ + (q * 4 + hq) * 128 + e0) = w; else *(u32x4*)(KC + ((size_t)hq * NTOK + row) * 128 + e0) = w;
                    }
                }
            }
            {
                const int c8 = lane & 31, rsel = lane >> 5;
                for (int rp = gw; rp < NTOK / 2; rp += ngw) {
                    const int row = rp * 2 + rsel;
                    const int slen = row < NPROMPT ? 8192 : 4096, pos = row & (slen - 1);
                    const bf16_t* ub = ZIN + (size_t)(row - pos) * NIN + C_PU + c8 * 8;
                    u32x4 xa[2], xb[4], xc[8], xd[16]; int ca = 0, cb = 0, cc = 0, cd = 0;
#define POOL_LD(X, W, G, CNT) do { _Pragma("unroll") for (int k = 0; k < (W); ++k) { const int t = pos - (W) / 2 + k; const bool ok = t >= 0 && t < slen; \
                        X[k] = ok ? *(const u32x4*)(ub + (size_t)(ok ? t : pos) * NIN + (G) * 256) : (u32x4){0u, 0u, 0u, 0u}; CNT += ok ? 1 : 0; } } while (0)
                    POOL_LD(xa, 2, 0, ca); POOL_LD(xb, 4, 1, cb); POOL_LD(xc, 8, 2, cc); POOL_LD(xd, 16, 3, cd);
#undef POOL_LD
#define POOL_OUT(X, W, G, CNT) do { float s_[8] = {0.f, 0.f, 0.f, 0.f, 0.f, 0.f, 0.f, 0.f}; \
                        _Pragma("unroll") for (int k = 0; k < (W); ++k) { s_[0] += bflo(X[k].x); s_[1] += bfhi(X[k].x); s_[2] += bflo(X[k].y); s_[3] += bfhi(X[k].y); s_[4] += bflo(X[k].z); s_[5] += bfhi(X[k].z); s_[6] += bflo(X[k].w); s_[7] += bfhi(X[k].w); } \
                        const u32x4 c_ = X[(W) / 2]; const float inv = 1.f / (float)(CNT); u32x4 w; \
                        w.x = cvt_pk_bf16(s_[0] * inv - bflo(c_.x), s_[1] * inv - bfhi(c_.x)); w.y = cvt_pk_bf16(s_[2] * inv - bflo(c_.y), s_[3] * inv - bfhi(c_.y)); \
                        w.z = cvt_pk_bf16(s_[4] * inv - bflo(c_.z), s_[5] * inv - bfhi(c_.z)); w.w = cvt_pk_bf16(s_[6] * inv - bflo(c_.w), s_[7] * inv - bfhi(c_.w)); \
                        *(u32x4*)(DPOOL + (size_t)row * 1024 + (G) * 256 + c8 * 8) = w; } while (0)
                    POOL_OUT(xa, 2, 0, ca); POOL_OUT(xb, 4, 1, cb); POOL_OUT(xc, 8, 2, cc); POOL_OUT(xd, 16, 3, cd);
#undef POOL_OUT
                }
            }
            if (gw == 0) {
                float gq_ = fmaxf(fabsf(a.q_norm[l * 128 + lane]), fabsf(a.q_norm[l * 128 + 64 + lane])), gk_ = fmaxf(fabsf(a.k_norm[l * 128 + lane]), fabsf(a.k_norm[l * 128 + 64 + lane]));
#pragma unroll
                for (int o_ = 1; o_ < 64; o_ <<= 1) { gq_ = fmaxf(gq_, shfl_from(gq_, lane ^ o_)); gk_ = fmaxf(gk_, shfl_from(gk_, lane ^ o_)); }
                if (lane == 0) *((float*)(ws + WS_ABOUND) + l) = 128.f * gq_ * gk_ * 1.02f;
            }
            for (int it = gw; it < 2 * 512 * 4; it += ngw) {
                const int head = it & 3, ck = (it >> 2) & 511, dir = it >> 11;
                const int tok = dir ? ck * 64 + 63 - lane : ck * 64 + lane;
                const float li = GATES[(size_t)tok * 16 + (dir ? 8 : 0) + head], lf = GATES[(size_t)tok * 16 + (dir ? 12 : 4) + head];
                const float b = ml::scan_add(lf, lane), av = li - b, cm = ml::scan_max(av, lane);
                *(f32x4*)(GSC + (((size_t)dir * NTOK + tok) * 4 + head) * 4) = (f32x4){av, cm, b, 0.f};
                if (lane == 63) *(f32x2*)(CHS + (((size_t)dir * 512 + ck) * 4 + head) * 2) = (f32x2){b, cm};
            }
        }
        SEAM(pb + 1);
        if (IN(pb + 2)) {
            PHASE_PTRS();
#if !defined(ONLY_PART) || ONLY_PART == 0
            for (int rep_ = 0; rep_ < PROBE_SMALLGEMM; ++rep_)
            { pg8::Gemm g{DPOOL, WPOOL, NTOK, 1024, 256, 1024, 256, 256}; pg8::StaticOrder S; S.init(NTOK, 1024, G, bx);
              Epi<1> E{Y, DM, a.pool_scale + l * 1024, ZIN + C_PZ, NIN, nullptr};
              pg8::gemm_phase<Epi<1>>(lds, g, S, E); }
#endif
            const float Rb = __int_as_float(__builtin_amdgcn_readfirstlane(__float_as_int(((const float*)(ws + WS_ABOUND))[l + (threadIdx.x >> 10)])));
            const bool noshift = Rb * (att::SCALE * 1.4426950408889634f) <= 57.f;
            for (int rep_ = 0; rep_ < PROBE_MIX; ++rep_) {
            if (threadIdx.x == 0) MISC[17] = 0u;
            for (int qi = 0; qi < 8; ++qi) {
                const int xq = (bx + qi) & 7;
                unsigned* qh = ctl + 8192 + 64 * ((l + 2 * rep_) * 8 + xq);
                for (;;) {
                    if (threadIdx.x == 0) MISC[16] = __hip_atomic_fetch_add(qh, 1u, __ATOMIC_RELAXED, __HIP_MEMORY_SCOPE_AGENT);
                    __syncthreads();
                    const int idx = __builtin_amdgcn_readfirstlane((int)MISC[16]);
                    __syncthreads();
                    if (idx >= 12 + 256 + NCOMB) break;
                    if (idx >= 12 + 256) {
                        if (__builtin_amdgcn_readfirstlane(threadIdx.x >> 6) == 0 && __builtin_amdgcn_readfirstlane((int)MISC[17]) == 0) {
                            KArgsP ap2_ = (KArgsP)__builtin_amdgcn_kernarg_segment_ptr(); asm volatile("" : "+s"(ap2_));
                            unsigned* md_ = (unsigned*)(ap2_->ws + WS_CTL) + 12288 + 64 * l;
                            unsigned sp_ = 0; while ((unsigned)__builtin_amdgcn_readfirstlane((int)xb_ld(md_)) < 96u * 64u * PROBE_MLSTM) { __builtin_amdgcn_s_sleep(1); if (++sp_ > XB_SPIN_CAP) break; }
                            __builtin_amdgcn_fence(__ATOMIC_ACQUIRE, "agent");
                            MISC[17] = 1u;
                        }
                        __syncthreads();
                        const int tid = opaque_tid(), lane = tid & 63, wave = __builtin_amdgcn_readfirstlane(tid >> 6);
                        const int it0 = ((xq * NCOMB + (idx - 268)) * 8 + wave) * 8;
#pragma unroll 2
                        for (int k = 0; k < 8; ++k) {
                            const int it = it0 + k;
                            const int row = it >> 1, head = (it & 1) * 2 + (lane >> 5), e0 = 8 * (lane & 31);
                            const size_t ho = (size_t)row * 1024 + head * 256 + e0;
                            const u32x4 xf = *(const u32x4*)(HF + ho), xb = *(const u32x4*)(HB + ho);
                            float v[8] = {bflo(xf.x) + bflo(xb.x), bfhi(xf.x) + bfhi(xb.x), bflo(xf.y) + bflo(xb.y), bfhi(xf.y) + bfhi(xb.y), bflo(xf.z) + bflo(xb.z), bfhi(xf.z) + bfhi(xb.z), bflo(xf.w) + bflo(xb.w), bfhi(xf.w) + bfhi(xb.w)};
                            float ss = 0.f;
#pragma unroll
                            for (int j = 0; j < 8; ++j) ss += v[j] * v[j];
                            ss = addx<1>(ss); ss = addx<2>(ss); ss = addx<4>(ss); ss = addx<8>(ss); ss = addx<16>(ss);
                            const float r = __builtin_amdgcn_rsqf(ss * (1.f / 256.f) + EPS);
                            const float* gn = a.mlstm_norm + l * 1024 + head * 256 + e0;
                            const f32x4 g0 = *(const f32x4*)gn, g1 = *(const f32x4*)(gn + 4);
                            const u32x4 mo = *(const u32x4*)(ZIN + (size_t)row * NIN + C_MO + head * 256 + e0), mz = *(const u32x4*)(ZIN + (size_t)row * NIN + C_MZ + head * 256 + e0);
                            u32x4 w;
                            w.x = cvt_pk_bf16(v[0] * r * g0[0] * bflo(mo.x) * bflo(mz.x), v[1] * r * g0[1] * bfhi(mo.x) * bfhi(mz.x));
                            w.y = cvt_pk_bf16(v[2] * r * g0[2] * bflo(mo.y) * bflo(mz.y), v[3] * r * g0[3] * bfhi(mo.y) * bfhi(mz.y));
                            w.z = cvt_pk_bf16(v[4] * r * g1[0] * bflo(mo.z) * bflo(mz.z), v[5] * r * g1[1] * bfhi(mo.z) * bfhi(mz.z));
                            w.w = cvt_pk_bf16(v[6] * r * g1[2] * bflo(mo.w) * bflo(mz.w), v[7] * r * g1[3] * bfhi(mo.w) * bfhi(mz.w));
                            *(u32x4*)(Y + (size_t)row * DM + 1024 + head * 256 + e0) = w;
                        }
                    } else if (idx < 12) {
                        int seq, head, dir, dvh;
                        if (idx < 4) { seq = xq >> 2; head = xq & 3; dir = (idx >> 1) & 1; dvh = idx & 1; }
                        else { const int j = 8 * xq + (idx - 4); seq = 2 + (j >> 4); head = (j >> 2) & 3; dir = (j >> 1) & 1; dvh = j & 1; }
                        const int seqrow = seq < 2 ? seq * 8192 : NPROMPT + (seq - 2) * 4096, seqlen = seq < 2 ? 8192 : 4096;
                        for (int rep_ = 0; rep_ < PROBE_MLSTM; ++rep_) {
                            ml::mlstm_item(lds, ZIN, GSC, CHS, dir ? HB : HF, seqrow, seqlen, head, dir, dvh);
                            VM_WAIT(); __syncthreads();
                            if (__builtin_amdgcn_readfirstlane(threadIdx.x >> 6) == 0) {
                                KArgsP ap2_ = (KArgsP)__builtin_amdgcn_kernarg_segment_ptr(); asm volatile("" : "+s"(ap2_));
                                unsigned* md_ = (unsigned*)(ap2_->ws + WS_CTL) + 12288 + 64 * l;
                                __builtin_amdgcn_fence(__ATOMIC_RELEASE, "agent"); (void)xb_add(md_, 1u); }
                        }
                    } else {
                        const int u = idx - 12;
                        int seqrow, seqlen, head, qb;
                        if (u < 128) { const int b = xq >> 2, kvh = xq & 3; head = kvh * 4 + (u >> 5); qb = u & 31; seqrow = b * 8192; seqlen = 8192; }
                        else { const int u2 = u - 128, grp = 2 * xq + (u2 >> 6), u3 = u2 & 63; const int b = grp >> 2, kvh = grp & 3; head = kvh * 4 + (u3 >> 4); qb = u3 & 15; seqrow = NPROMPT + b * 4096; seqlen = 4096; }
                        const int kvh = head >> 2;
                        const bf16_t* Qb = ZIN + (size_t)(seqrow + qb * 256) * NIN + C_AQ + head * 128;
                        const bf16_t* Kh = KC + ((size_t)kvh * NTOK + seqrow) * 128;
                        const bf16_t* Vh = ZIN + (size_t)seqrow * NIN + C_AV + kvh * 128;
                        const bf16_t* Zb = ZIN + (size_t)(seqrow + qb * 256) * NIN + C_AZ + head * 128;
                        bf16_t* Yb = Y + (size_t)(seqrow + qb * 256) * DM + 2048 + head * 128;
                        for (int rep_ = 0; rep_ < PROBE_ATTN; ++rep_) { if (noshift) att::attn_unit<true>(Qb, Kh, Vh, Zb, Yb, seqlen, (char*)lds_raw, lds); else att::attn_unit<false>(Qb, Kh, Vh, Zb, Yb, seqlen, (char*)lds_raw, lds); }
                    }
                }
            }
            }
        }
        SEAM(pb + 2);
        if (IN(pb + 4)) for (int rep_ = 0; rep_ < PROBE_OUTPROJ; ++rep_) {
            PHASE_PTRS();
            pg8::Gemm g{Y, WOUT, NTOK, DM, DM, DM, DM, 0}; pg8::StaticOrder S; S.init(NTOK, DM, G, bx);
            Epi<3> E{YO, DM, nullptr, nullptr, 0, STATS};
            pg8::gemm_phase<Epi<3>>(lds, g, S, E);
        }
        SEAM(pb + 4);
        if (IN(pb + 5)) {
            PHASE_PTRS();
            const bool gemm_first = ((bx >> 3) & 1) == 0;
            for (int pass_ = 0; pass_ < 2; ++pass_) {
            if ((pass_ == 0) == gemm_first) {
            for (int rep_ = 0; rep_ < PROBE_SMALLGEMM; ++rep_)
            { pg8::Gemm g{PB + (size_t)l * NTOK * PLE, WPROJ, NTOK, DM, PLE, PLE, PLE, 0}; pg8::StaticOrder S; S.init(NTOK, DM, G, bx);
              Epi<2> E{PP, DM, nullptr, nullptr, 0, nullptr};
              pg8::gemm_phase<Epi<2>>(lds, g, S, E); }
            } else {
            PHASE_IDS();
            for (int rep_ = 0; rep_ < PROBE_X1; ++rep_)
            for (int row = gw; row < NTOK; row += ngw) {
                const float st = STATS[(size_t)row * 64 + lane];
                const float rstd = __builtin_amdgcn_rsqf(wave_sum(st) * (1.f / DM) + EPS);
                const f32x4* xr = (const f32x4*)xrow_ptr(a, row) + 2 * lane;
                const u32x4* xb = (const u32x4*)((const bf16_t*)a.out + (size_t)row * DM) + lane;
                const u32x4* yr = (const u32x4*)(YO + (size_t)row * DM) + lane;
                const f32x4* gr = (const f32x4*)(a.norm_post + (size_t)l * DM) + 2 * lane;
                u32x4* hr = (u32x4*)(H + (size_t)row * DM) + lane;
                f32x4 xv[8][2]; u32x4 pv[8];
#pragma unroll
                for (int j = 0; j < 8; ++j) {
                    if (l == 0) { xv[j][0] = __builtin_nontemporal_load(xr + 128 * j); xv[j][1] = __builtin_nontemporal_load(xr + 128 * j + 1); }
                    else { const u32x4 t = __builtin_nontemporal_load(xb + 64 * j); xv[j][0] = (f32x4){bflo(t.x), bfhi(t.x), bflo(t.y), bfhi(t.y)}; xv[j][1] = (f32x4){bflo(t.z), bfhi(t.z), bflo(t.w), bfhi(t.w)}; }
                    pv[j] = __builtin_nontemporal_load(yr + 64 * j); }
#pragma unroll
                for (int j = 0; j < 8; ++j) { const f32x4 x0 = xv[j][0], x1 = xv[j][1]; const u32x4 p = pv[j]; const f32x4 g0 = gr[128 * j], g1 = gr[128 * j + 1];
                    u32x4 o;
                    o.x = cvt_pk_bf16(x0[0] + bflo(p.x) * rstd * g0[0], x0[1] + bfhi(p.x) * rstd * g0[1]); o.y = cvt_pk_bf16(x0[2] + bflo(p.y) * rstd * g0[2], x0[3] + bfhi(p.y) * rstd * g0[3]);
                    o.z = cvt_pk_bf16(x1[0] + bflo(p.z) * rstd * g1[0], x1[1] + bfhi(p.z) * rstd * g1[1]); o.w = cvt_pk_bf16(x1[2] + bflo(p.w) * rstd * g1[2], x1[3] + bfhi(p.w) * rstd * g1[3]);
                    hr[64 * j] = o; }
            }
            }
            }
        }
        SEAM(pb + 5);
        for (int rep_ = 0; rep_ < PROBE_BAR; ++rep_) SEAM(pb + 5);
        if (IN(pb + 6)) for (int rep_ = 0; rep_ < PROBE_GATE; ++rep_) {
            PHASE_PTRS();
            pg8::Gemm g{H, WGATE, NTOK, DM, DM, DM, DM, 0}; pg8::StaticOrder S; S.init(NTOK, DM, G, bx);
            Epi<4> E{Y, DM, nullptr, PP, DM, STATS};
            pg8::gemm_phase<Epi<4>>(lds, g, S, E);
        }
        SEAM(pb + 6);
        if (IN(pb + 7)) { PHASE_PTRS(); PHASE_IDS(); if (l + 1 < DEPTH) convert_layer_weights(a, l + 1, gw, ngw, (LAS float*)(lds + wave * 16384), lane); norm_gates_phase<1>(a, l + 1, l, gw, ngw, lane); }
        if (l + 1 < DEPTH) SEAM(pb + 7);

}

__global__ void __launch_bounds__(NWAVES * 64, 2) fwd_kernel(Args a) {
    extern __shared__ __attribute__((aligned(16))) unsigned char lds_raw[];
    LAS unsigned char* lds = (LAS unsigned char*)lds_raw;
    volatile LAS unsigned* MISC = (volatile LAS unsigned*)(lds + MISC_OFF);
    const int G = gridDim.x, bx = blockIdx.x;
    const int vcu = (G % 8 == 0) ? (bx % 8) * (G / 8) + bx / 8 : bx;
    const int ngw = G * NWAVES, ngt = G * NWAVES * 64;
    if (threadIdx.x < 64) MISC[threadIdx.x] = 0u;
    __syncthreads();
#if MK_ONE_LAUNCH
    XcdBarrier bar = xcd_barrier_post((unsigned*)(a.ws + WS_CTL) + 4096, MISC + 8);
#else
    XcdBarrier bar; bar.bar = nullptr; bar.x = 0; bar.st = nullptr;
#endif
    const int lo = a.ph_lo, hi = a.ph_hi;
    if (IN(PH_PRO)) for (int rep_ = 0; rep_ < PROBE_PRO; ++rep_) {
        PHASE_PTRS(); PHASE_IDS();
        LAS float* scr = (LAS float*)(lds + wave * 16384);
        convert_layer_weights(a, 0, gw, ngw, scr, lane);
        for (int i = gt; i < DEPTH * 16 * DM; i += ngt) { const int l = i / (16 * DM), r = i % (16 * DM), gcol = r / DM, k = r % DM; WG[i] = f2bf(a.w_in[(size_t)l * DM * NINSRC + (size_t)k * NINSRC + 7168 + gcol]); }
        for (int i = gt; i < DEPTH * NTOK * PLE / 8; i += ngt) {
            const size_t e = (size_t)i * 8; const int l = (int)(e / ((size_t)NTOK * PLE)); const size_t r = e % ((size_t)NTOK * PLE);
            const float* src = r < (size_t)NPROMPT * PLE ? a.p_prompt + (size_t)l * NPROMPT * PLE + r : a.p_sample + (size_t)l * NPROMPT * PLE + (r - (size_t)NPROMPT * PLE);
            const f32x4 x0 = *(const f32x4*)src, x1 = *(const f32x4*)(src + 4);
            u32x4 o; o.x = cvt_pk_bf16(x0[0], x0[1]); o.y = cvt_pk_bf16(x0[2], x0[3]); o.z = cvt_pk_bf16(x1[0], x1[1]); o.w = cvt_pk_bf16(x1[2], x1[3]);
            *(u32x4*)(PB + e) = o;
        }
        for (int i = gt; i < 128 * 32; i += ngt) {
            const int pos = i >> 5, f = i & 31;
            const double ang = (double)pos * ROPE_INV[f];
            const double kk = __builtin_rint(ang * 0.15915494309189535), r = ang - kk * 6.283185307179586, r2 = r * r;
            double cs = 1.0, sn = r, tc = 1.0, tsn = r;
            for (int n = 1; n <= 16; ++n) { tc *= -r2 / (double)((2 * n - 1) * (2 * n)); cs += tc; tsn *= -r2 / (double)((2 * n) * (2 * n + 1)); sn += tsn; }
            ROPE[i] = (f32x2){(float)cs, (float)sn};
        }
    }
    SEAM(PH_PRO);
    if (IN(PH_NORM0)) for (int rep_ = 0; rep_ < PROBE_PRO; ++rep_) { PHASE_PTRS(); PHASE_IDS(); norm_gates_phase<0>(a, 0, 0, gw, ngw, lane); }
    SEAM(PH_NORM0);

    layer_body<0>(lds, lds_raw, MISC, bar, G, bx, vcu, ngw, ngt, lo, hi);
    layer_body<1>(lds, lds_raw, MISC, bar, G, bx, vcu, ngw, ngt, lo, hi);
    static_assert(DEPTH == 2, "two layer_body instantiations");
}


extern "C" void kernel_launch(void* const* d_in, const int* in_sizes, int n_in, void* d_out, int out_size, void* d_ws, size_t ws_size, hipStream_t stream) {
    static int grid = 0;
    if (grid == 0) {
        if (n_in != 17 || out_size != NTOK * DM || ws_size < WS_END) { fprintf(stderr, "kernel_launch: unexpected shapes: n_in %d out %d ws %zu (need %zu)\n", n_in, out_size, ws_size, (size_t)WS_END); grid = -1; return; }
        int dev = 0, cus = 0, per_cu = 0;
        if (hipGetDevice(&dev) != hipSuccess || hipDeviceGetAttribute(&cus, hipDeviceAttributeMultiprocessorCount, dev) != hipSuccess) { grid = -1; return; }
        if (hipFuncSetAttribute((const void*)fwd_kernel, hipFuncAttributeMaxDynamicSharedMemorySize, LDS_BYTES) != hipSuccess) { fprintf(stderr, "kernel_launch: hipFuncSetAttribute failed\n"); grid = -1; return; }
        if (hipOccupancyMaxActiveBlocksPerMultiprocessor(&per_cu, (const void*)fwd_kernel, NWAVES * 64, LDS_BYTES) != hipSuccess || per_cu < 1) { fprintf(stderr, "kernel_launch: occupancy query says %d\n", per_cu); }
        (void)hipGetLastError();
        grid = cus;
    }
    if (grid < 0) return;
    (void)hipMemsetAsync((char*)d_ws + WS_CTL, 0, CTL_ZERO_BYTES, stream);
    Args a{};
    a.x_prompt = (const float*)d_in[0]; a.x_sample = (const float*)d_in[1]; a.p_prompt = (const float*)d_in[2]; a.p_sample = (const float*)d_in[3];
    a.norm_pre = (const float*)d_in[4]; a.w_in = (const float*)d_in[5]; a.b_gate = (const float*)d_in[6]; a.w_pool = (const float*)d_in[7]; a.pool_scale = (const float*)d_in[8];
    a.mlstm_norm = (const float*)d_in[9]; a.q_norm = (const float*)d_in[10]; a.k_norm = (const float*)d_in[11]; a.w_out = (const float*)d_in[12]; a.norm_post = (const float*)d_in[13];
    a.w_ple_proj = (const float*)d_in[14]; a.w_ple_gate = (const float*)d_in[15]; a.ple_norm = (const float*)d_in[16];
    a.out = (float*)d_out; a.ws = (unsigned char*)d_ws;
#if MK_ONE_LAUNCH
    a.ph_lo = 0; a.ph_hi = N_PHASES;
    hipLaunchKernelGGL(fwd_kernel, dim3(grid), dim3(NWAVES * 64), LDS_BYTES, stream, a);
#else
    for (int p = 0; p < N_PHASES; ++p) { a.ph_lo = p; a.ph_hi = p + 1; hipLaunchKernelGGL(fwd_kernel, dim3(grid), dim3(NWAVES * 64), LDS_BYTES, stream, a); }
#endif
    const hipError_t le = hipPeekAtLastError();
    if (le != hipSuccess) fprintf(stderr, "kernel_launch: launch failed: %s\n", hipGetErrorName(le));
}
```
